# Optimizing an MI355X kernel written in HIP

```python
import math
import jax, jax.numpy as jnp
from jax import lax
import numpy as np

D_MODEL = 2048
BATCH = 4
SEQ = 4096
DEPTH = 1

MEM_LEN = 256
EPS = 1e-6
HEAD_DIM_A = 128
WIDTH_A = (3 * D_MODEL) // 4
N_Q_HEADS_A = WIDTH_A // HEAD_DIM_A
N_KV_HEADS_A = N_Q_HEADS_A // 3
KV_WIDTH_A = N_KV_HEADS_A * HEAD_DIM_A
WINDOW = 128
BLOCK = 128
WIDTH_B = (3 * D_MODEL) // 4
CHUNK = 128
GROUP_DIM_B = 128
N_GROUPS_B = WIDTH_B // GROUP_DIM_B
N_HEADS_C = 4
WIDTH_C = D_MODEL // 2
HEAD_DIM_C = WIDTH_C // N_HEADS_C
N_BRANCH = 3
IN_SPLITS = [WIDTH_A, KV_WIDTH_A, KV_WIDTH_A, WIDTH_A,
             WIDTH_B, WIDTH_B, WIDTH_B,
             WIDTH_C, WIDTH_C,
             N_BRANCH * D_MODEL]
N_IN = sum(IN_SPLITS)
NEG_INF = -1e30

kernel_name = "hybrid_gated_window_gmlp_memxattn"


def rmsnorm(x, gain):
    xf = x.astype(jnp.float32)
    xf = xf * lax.rsqrt(jnp.mean(xf * xf, axis=-1, keepdims=True) + EPS)
    return (xf * gain.astype(jnp.float32)).astype(x.dtype)


def layernorm(x, gain, bias):
    xf = x.astype(jnp.float32)
    mu = jnp.mean(xf, axis=-1, keepdims=True)
    xc = xf - mu
    var = jnp.mean(xc * xc, axis=-1, keepdims=True)
    y = xc * lax.rsqrt(var + EPS) * gain.astype(jnp.float32) + bias.astype(jnp.float32)
    return y.astype(x.dtype)


def alibi_slopes(n):
    def pow2_slopes(m):
        start = 2.0 ** (-8.0 / m)
        return [start ** (i + 1) for i in range(m)]
    if math.log2(n).is_integer():
        s = pow2_slopes(n)
    else:
        c = 2 ** int(math.floor(math.log2(n)))
        s = pow2_slopes(c) + pow2_slopes(2 * c)[0::2][: n - c]
    return np.asarray(s, dtype=np.float32)


def windowed_gqa_sink(q, k, v, sink):
    B, S, Hq, Dh = q.shape
    Hkv = k.shape[2]
    rep = Hq // Hkv
    nb = S // BLOCK
    qb = q.reshape(B, nb, BLOCK, Hkv, rep, Dh)
    pad = ((0, 0), (BLOCK, BLOCK), (0, 0), (0, 0))
    kp = jnp.pad(k, pad).reshape(B, nb + 2, BLOCK, Hkv, Dh)
    vp = jnp.pad(v, pad).reshape(B, nb + 2, BLOCK, Hkv, Dh)
    kb = jnp.concatenate([kp[:, :-2], kp[:, 1:-1], kp[:, 2:]], axis=2)
    vb = jnp.concatenate([vp[:, :-2], vp[:, 1:-1], vp[:, 2:]], axis=2)
    scale = 1.0 / math.sqrt(Dh)
    scores = jnp.einsum('bnqhrd,bnkhd->bnhrqk', qb, kb).astype(jnp.float32) * scale
    t = jnp.arange(BLOCK)[:, None]
    j = jnp.arange(3 * BLOCK)[None, :]
    dist = jnp.abs(t - (j - BLOCK))
    key_pos = (jnp.arange(nb)[:, None] - 1) * BLOCK + jnp.arange(3 * BLOCK)[None, :]
    valid = (dist <= WINDOW)[None] & ((key_pos >= 0) & (key_pos < S))[:, None, :]
    slopes = jnp.asarray(alibi_slopes(Hq)).reshape(Hkv, rep)
    alibi = -slopes[:, :, None, None] * dist.astype(jnp.float32)[None, None]
    scores = scores + alibi[None, None]
    scores = jnp.where(valid[None, :, None, None], scores, NEG_INF)
    sink_col = jnp.broadcast_to(sink.astype(jnp.float32).reshape(1, 1, Hkv, rep, 1, 1),
                                scores.shape[:-1] + (1,))
    probs = jax.nn.softmax(jnp.concatenate([scores, sink_col], axis=-1), axis=-1)[..., :-1]
    out = jnp.einsum('bnhrqk,bnkhd->bnqhrd', probs.astype(v.dtype), vb)
    return out.reshape(B, S, Hq * Dh)


def chunked_spatial_gating(u, v, ln_gain, ln_bias, w_s, b_s):
    B, S, _ = u.shape
    u = jax.nn.gelu(u, approximate=False)
    v = layernorm(jax.nn.gelu(v, approximate=False), ln_gain, ln_bias)
    vc = v.reshape(B, S // CHUNK, CHUNK, N_GROUPS_B, GROUP_DIM_B)
    s = jnp.einsum('gts,bcsgd->bctgd', w_s, vc) + b_s.T[None, None, :, :, None]
    return u * s.reshape(B, S, WIDTH_B)


def memory_cross_attention(q, mem_h, w_kv_mem):
    B, S, _ = q.shape
    M = mem_h.shape[1]
    kv = mem_h @ w_kv_mem
    k, v = jnp.split(kv, 2, axis=-1)
    qh = q.reshape(B, S, N_HEADS_C, HEAD_DIM_C)
    kh = k.reshape(B, M, N_HEADS_C, HEAD_DIM_C)
    vh = v.reshape(B, M, N_HEADS_C, HEAD_DIM_C)
    scores = jnp.einsum('bshd,bmhd->bhsm', qh, kh).astype(jnp.float32) / math.sqrt(HEAD_DIM_C)
    probs = jax.nn.softmax(scores, axis=-1).astype(vh.dtype)
    out = jnp.einsum('bhsm,bmhd->bshd', probs, vh)
    return out.reshape(B, S, WIDTH_C)


def setup_inputs(seed: int = 0) -> dict:
    key = jax.random.key(seed)
    ks = jax.random.split(key, 20)
    f = jnp.float32
    nrm = lambda k, shape, scale: jax.random.normal(k, shape, f) * scale
    return {
        "x": nrm(ks[0], (BATCH, SEQ, D_MODEL), 1.0),
        "mem": nrm(ks[1], (BATCH, MEM_LEN, D_MODEL), 1.0),
        "norm_gain": 1.0 + nrm(ks[2], (DEPTH, D_MODEL), 0.02),
        "mem_norm_gain": 1.0 + nrm(ks[3], (DEPTH, D_MODEL), 0.02),
        "w_in": nrm(ks[4], (DEPTH, D_MODEL, N_IN), D_MODEL ** -0.5),
        "sink": nrm(ks[5], (DEPTH, N_Q_HEADS_A), 0.5),
        "ln_v_gain": 1.0 + nrm(ks[6], (DEPTH, WIDTH_B), 0.02),
        "ln_v_bias": nrm(ks[7], (DEPTH, WIDTH_B), 0.01),
        "w_spatial": nrm(ks[8], (DEPTH, N_GROUPS_B, CHUNK, CHUNK), CHUNK ** -0.5),
        "b_spatial": 1.0 + nrm(ks[9], (DEPTH, N_GROUPS_B, CHUNK), 0.01),
        "w_kv_mem": nrm(ks[10], (DEPTH, D_MODEL, 2 * WIDTH_C), D_MODEL ** -0.5),
        "w_br_a": nrm(ks[11], (DEPTH, WIDTH_A, D_MODEL), WIDTH_A ** -0.5),
        "w_br_b": nrm(ks[12], (DEPTH, WIDTH_B, D_MODEL), WIDTH_B ** -0.5),
        "w_br_c": nrm(ks[13], (DEPTH, WIDTH_C, D_MODEL), WIDTH_C ** -0.5),
        "w_out": nrm(ks[14], (DEPTH, D_MODEL, D_MODEL), D_MODEL ** -0.5),
        "final_gain": 1.0 + nrm(ks[15], (D_MODEL,), 0.02),
    }


def reference(x, mem, norm_gain, mem_norm_gain, w_in, sink, ln_v_gain, ln_v_bias,
              w_spatial, b_spatial, w_kv_mem, w_br_a, w_br_b, w_br_c, w_out, final_gain):
    B, S, D = x.shape
    split_idx = [int(c) for c in np.cumsum(IN_SPLITS)[:-1]]
    for l in range(DEPTH):
        h = rmsnorm(x, norm_gain[l])
        proj = h @ w_in[l]
        (q_a, k_a, v_a, z_a, u_b, v_b, z_b, q_c, z_c, gates) = jnp.split(proj, split_idx, axis=-1)
        o_a = windowed_gqa_sink(q_a.reshape(B, S, N_Q_HEADS_A, HEAD_DIM_A),
                                k_a.reshape(B, S, N_KV_HEADS_A, HEAD_DIM_A),
                                v_a.reshape(B, S, N_KV_HEADS_A, HEAD_DIM_A),
                                sink[l])
        o_a = o_a * jax.nn.silu(z_a)
        o_b = chunked_spatial_gating(u_b, v_b, ln_v_gain[l], ln_v_bias[l], w_spatial[l], b_spatial[l])
        o_b = o_b * jax.nn.silu(z_b)
        mem_h = rmsnorm(mem, mem_norm_gain[l])
        o_c = memory_cross_attention(q_c, mem_h, w_kv_mem[l]) * jax.nn.silu(z_c)
        g_a, g_b, g_c = jnp.split(jax.nn.sigmoid(gates), N_BRANCH, axis=-1)
        merged = (o_a @ w_br_a[l]) * g_a + (o_b @ w_br_b[l]) * g_b + (o_c @ w_br_c[l]) * g_c
        x = x + merged @ w_out[l]
    return rmsnorm(x, final_gain)
```

```cpp
#include <hip/hip_runtime.h>
#include <hip/hip_cooperative_groups.h>
#include <cstdio>
#include <cstdint>
namespace cg = cooperative_groups;

#ifndef MK_MULTI
#define MK_MULTI 0
#endif

#define LAS __attribute__((address_space(3)))
#define GAS __attribute__((address_space(1)))
typedef unsigned short bf16_t;
typedef short bf16x8 __attribute__((ext_vector_type(8)));
typedef float f32x4 __attribute__((ext_vector_type(4)));
typedef float f32x2 __attribute__((ext_vector_type(2)));
typedef unsigned u32x4 __attribute__((ext_vector_type(4)));
typedef unsigned u32x2 __attribute__((ext_vector_type(2)));

constexpr int DM = 2048, NB = 4, SEQ = 4096, M = NB * SEQ, MEML = 256, MM = NB * MEML;
constexpr int N_IN = 16896;
constexpr int QKZ_LD = 7168;
constexpr int OB_LD = 4096;
constexpr float EPS = 1e-6f;
constexpr float LOG2E = 1.4426950408889634f;

constexpr size_t MiB = 1u << 20;
constexpr size_t WS_WINT = 1 * MiB;
constexpr size_t WS_H = 67 * MiB;
constexpr size_t WS_WKVT = 131 * MiB;
constexpr size_t WS_MEMH = 139 * MiB;
constexpr size_t WS_WBRT = 143 * MiB;
constexpr size_t WS_WOUTT = 159 * MiB;
constexpr size_t WS_QKZ = 167 * MiB;
constexpr size_t WS_SG = WS_QKZ, WS_SM = WS_QKZ + 32 * MiB, WS_MERGED = WS_QKZ + 96 * MiB;
constexpr size_t WS_OB = 391 * MiB;
constexpr size_t WS_KMEM = 519 * MiB;
constexpr size_t WS_VMEMT = 521 * MiB;
constexpr size_t WS_PART1 = 523 * MiB;
constexpr size_t WS_PART2 = 525 * MiB;
constexpr size_t WS_END = 527 * MiB;
constexpr size_t DO_VAT = 0, DO_VBT = 16 * MiB;

constexpr int LDS_BYTES = 147456;
constexpr int NWAVES = 8;

typedef __bf16 bf16x2_t __attribute__((ext_vector_type(2)));
__device__ __forceinline__ unsigned cvt_pk_bf16(float lo, float hi) { const f32x2 v = {lo, hi}; const bf16x2_t b = __builtin_convertvector(v, bf16x2_t); return __builtin_bit_cast(unsigned, b); }
__device__ __forceinline__ float bf_lo(unsigned w) { return __uint_as_float(w << 16); }
__device__ __forceinline__ float bf_hi(unsigned w) { return __uint_as_float(w & 0xffff0000u); }
__device__ __forceinline__ float sigmoidf_(float x) { return __builtin_amdgcn_rcpf(1.0f + __builtin_amdgcn_exp2f(-LOG2E * x)); }
__device__ __forceinline__ float siluf_(float x) { return x * sigmoidf_(x); }
__device__ __forceinline__ f32x4 silu4(f32x4 v) { return (f32x4){siluf_(v[0]), siluf_(v[1]), siluf_(v[2]), siluf_(v[3])}; }
__device__ __forceinline__ f32x4 sigmoid4(f32x4 v) { return (f32x4){sigmoidf_(v[0]), sigmoidf_(v[1]), sigmoidf_(v[2]), sigmoidf_(v[3])}; }
__device__ __forceinline__ f32x2 gelu_pk(f32x2 v) {
    const f32x2 av = __builtin_elementwise_abs(v), d = av * 0.2316418882f + 1.0f;
    f32x2 t; t.x = __builtin_amdgcn_rcpf(d.x); t.y = __builtin_amdgcn_rcpf(d.y);
    f32x2 q = t * 0.5307027145f + (-0.7265760135f); q = q * t + 0.7107068705f; q = q * t + (-0.142248368f); q = q * t + 0.127414796f; q = q * t;
    const f32x2 s = (v * v) * (-0.72134752044f);
    f32x2 e; e.x = __builtin_amdgcn_exp2f(s.x); e.y = __builtin_amdgcn_exp2f(s.y);
    const f32x2 m = v * (q * e), r = v - m;
    f32x2 o; o.x = v.x < 0.f ? m.x : r.x; o.y = v.y < 0.f ? m.y : r.y; return o;
}
__device__ __forceinline__ f32x4 gelu4(f32x4 v) { const f32x2 a = gelu_pk((f32x2){v[0], v[1]}), b = gelu_pk((f32x2){v[2], v[3]}); return (f32x4){a.x, a.y, b.x, b.y}; }
__device__ __forceinline__ u32x4 pack8(f32x4 a, f32x4 b) { u32x4 w; w.x = cvt_pk_bf16(a[0], a[1]); w.y = cvt_pk_bf16(a[2], a[3]); w.z = cvt_pk_bf16(b[0], b[1]); w.w = cvt_pk_bf16(b[2], b[3]); return w; }
__device__ __forceinline__ float wave_sum(float v) {
#pragma unroll
    for (int o = 1; o < 64; o <<= 1) v += __shfl_xor(v, o);
    return v;
}

namespace pg8 {
constexpr int BM = 256, BK = 64, HALF = 128, HTB = HALF * BK * 2, STAGE_BYTES = 8 * HTB;
__host__ __device__ __forceinline__ int lds_byte(int r, int c) { const int st = (r >> 4) * 2 + (c >> 5), rr = r & 15, cc = c & 31, ob = rr * 64 + cc * 2; return st * 1024 + (ob ^ (((ob >> 9) & 1) << 5)); }
__host__ __device__ __forceinline__ void stage_rc(int b, int& R, int& C) { const int st = b / 1024, sb = b % 1024, swz = sb ^ (((sb >> 9) & 1) << 5); R = (st >> 1) * 16 + swz / 64; C = (st & 1) * 32 + (swz % 64) / 2; }
__host__ __device__ __forceinline__ int perm32(int rho) { const int n = rho >> 4, i = rho & 15; return 8 * (i >> 2) + 4 * n + (i & 3); }

struct Unit { const char* A; const char* B; bf16_t* O; float* st; int nt; unsigned pitch; int ldc; int kind; int pm, pn; };

template <class Epi, class Sched>
__device__ __forceinline__ void gemm_phase(LAS unsigned char* lds, const Sched& S, const Epi& E) {
    const int tid = threadIdx.x, wid = __builtin_amdgcn_readfirstlane(tid >> 6), lane = tid & 63, wr = wid >> 2, wc = wid & 3, fr = lane & 15, fq = lane >> 4;
    unsigned rA, rB, cb;
    { int R, C; stage_rc(tid * 16, R, C); rA = (unsigned)R; rB = (unsigned)((R & ~31) + perm32(R & 31)); cb = (unsigned)C * 2u; }
    const unsigned ldsw = (unsigned)wid * 1024u;
    const int aoff = lds_byte(wr * 64 + fr, fq * 8), boff = lds_byte(wc * 32 + fr, fq * 8);
#define PG8_SA(b, h) (((b) * 2 + (h)) * HTB)
#define PG8_SB(b, h) ((4 + (b) * 2 + (h)) * HTB)
#define PG8_STAGE(bufoff, gbase, rr, pit) do { const unsigned o_ = (rr) * (pit) + cb; \
        __builtin_amdgcn_global_load_lds((const unsigned*)((const char*)(gbase) + o_), (LAS unsigned*)(lds + (bufoff) + ldsw), 16, 0, 0); \
        __builtin_amdgcn_global_load_lds((const unsigned*)((const char*)(gbase) + o_ + 64u * (pit)), (LAS unsigned*)(lds + (bufoff) + ldsw + 8192), 16, 0, 0); } while (0)
#define PG8_LDA(dst, b, h) do { _Pragma("unroll") for (int m = 0; m < 4; ++m) _Pragma("unroll") for (int k = 0; k < 2; ++k) dst[m][k] = *(const LAS bf16x8*)(lds + PG8_SA(b, h) + aoff + m * 2048 + k * 1024); } while (0)
#define PG8_LDB(dst, b, h) do { _Pragma("unroll") for (int n = 0; n < 2; ++n) _Pragma("unroll") for (int k = 0; k < 2; ++k) dst[n][k] = *(const LAS bf16x8*)(lds + PG8_SB(b, h) + boff + n * 2048 + k * 1024); } while (0)
#define PG8_MMA(ai, bj, At, Bt) do { __builtin_amdgcn_s_setprio(1); _Pragma("unroll") for (int m = 0; m < 4; ++m) _Pragma("unroll") for (int n = 0; n < 2; ++n) _Pragma("unroll") for (int k = 0; k < 2; ++k) \
        acc[ai][bj][m][n] = __builtin_amdgcn_mfma_f32_16x16x32_bf16(Bt[n][k], At[m][k], acc[ai][bj][m][n], 0, 0, 0); __builtin_amdgcn_s_setprio(0); } while (0)
#define PG8_WAIT_V(n) asm volatile("s_waitcnt vmcnt(" #n ")" ::: "memory")
#define PG8_WAIT_L(n) asm volatile("s_waitcnt lgkmcnt(" #n ")" ::: "memory")
#define PG8_BAR __builtin_amdgcn_s_barrier()
#define PG8_SCHED __builtin_amdgcn_sched_barrier(0)
    Unit cur, nxt; int ui = 0;
    if (!S.next(0, cur)) return;
    f32x4 acc[2][2][4][2];
#pragma unroll
    for (int a = 0; a < 2; ++a)
#pragma unroll
        for (int b = 0; b < 2; ++b)
#pragma unroll
            for (int m = 0; m < 4; ++m)
#pragma unroll
                for (int n = 0; n < 2; ++n) acc[a][b][m][n] = (f32x4){0.f, 0.f, 0.f, 0.f};
    bf16x8 At[4][2], B0[2][2], B1[2][2];
    const char* cA = cur.A; const char* cB = cur.B;
    const size_t kstep = (size_t)(BK * 2);
    {
        const unsigned pc = cur.pitch; const size_t hc = (size_t)HALF * pc;
        PG8_STAGE(PG8_SB(0, 0), cB, rB, pc); PG8_STAGE(PG8_SB(0, 1), cB + hc, rB, pc); PG8_STAGE(PG8_SA(0, 0), cA, rA, pc); PG8_STAGE(PG8_SA(0, 1), cA + hc, rA, pc);
        if (wr == 1) PG8_BAR;
        PG8_WAIT_V(2); PG8_BAR;
        PG8_STAGE(PG8_SB(1, 0), cB + kstep, rB, pc); PG8_STAGE(PG8_SA(1, 0), cA + kstep, rA, pc); PG8_STAGE(PG8_SB(1, 1), cB + hc + kstep, rB, pc);
        PG8_WAIT_V(6); PG8_BAR;
    }
    for (;;) {
        const bool has_next = S.next(ui + 1, nxt);
        const char* nA = has_next ? nxt.A : cA; const char* nB = has_next ? nxt.B : cB;
        const unsigned pc = cur.pitch, pnx = has_next ? nxt.pitch : cur.pitch; const size_t hc = (size_t)HALF * pc;
        const int nt = cur.nt;
        for (int t = 0; t < nt; t += 2) {
            const bool last = (t == nt - 2);
            const char* a1 = cA + (size_t)(t + 1) * kstep;
            const char* a2 = last ? nA : cA + (size_t)(t + 2) * kstep; const char* b2 = last ? nB : cB + (size_t)(t + 2) * kstep;
            const unsigned p2 = last ? pnx : pc; const size_t h2 = (size_t)HALF * p2;
            const char* a3 = a2 + kstep; const char* b3 = b2 + kstep;
            PG8_LDB(B0, 0, 0); PG8_LDB(B1, 0, 1); PG8_SCHED; PG8_LDA(At, 0, 0); PG8_STAGE(PG8_SA(1, 1), a1 + hc, rA, pc);
            PG8_WAIT_V(8); PG8_WAIT_L(0); PG8_BAR; PG8_MMA(0, 0, At, B0); PG8_MMA(0, 1, At, B1); PG8_BAR; PG8_SCHED;
            PG8_LDA(At, 0, 1); PG8_STAGE(PG8_SB(0, 0), b2, rB, p2); PG8_STAGE(PG8_SB(0, 1), b2 + h2, rB, p2); PG8_STAGE(PG8_SA(0, 0), a2, rA, p2);
            PG8_WAIT_V(8); PG8_WAIT_L(0); PG8_BAR; PG8_MMA(1, 0, At, B0); PG8_MMA(1, 1, At, B1); PG8_BAR; PG8_SCHED;
            PG8_LDB(B0, 1, 0); PG8_LDB(B1, 1, 1); PG8_SCHED; PG8_LDA(At, 1, 0); PG8_STAGE(PG8_SA(0, 1), a2 + h2, rA, p2);
            PG8_WAIT_V(8); PG8_WAIT_L(0); PG8_BAR; PG8_MMA(0, 0, At, B0); PG8_MMA(0, 1, At, B1); PG8_BAR; PG8_SCHED;
            PG8_LDA(At, 1, 1); PG8_STAGE(PG8_SB(1, 0), b3, rB, p2); PG8_STAGE(PG8_SB(1, 1), b3 + h2, rB, p2); PG8_STAGE(PG8_SA(1, 0), a3, rA, p2);
            PG8_WAIT_V(8); PG8_WAIT_L(0); PG8_BAR; PG8_MMA(1, 0, At, B0); PG8_MMA(1, 1, At, B1); PG8_BAR; PG8_SCHED;
        }
        if (wr == 0) PG8_BAR;
        E(acc, cur, wr, wc, fr, fq);
        if (!has_next) break;
#pragma unroll
        for (int a = 0; a < 2; ++a)
#pragma unroll
            for (int b = 0; b < 2; ++b)
#pragma unroll
                for (int m = 0; m < 4; ++m)
#pragma unroll
                    for (int n = 0; n < 2; ++n) acc[a][b][m][n] = (f32x4){0.f, 0.f, 0.f, 0.f};
        cur = nxt; cA = nA; cB = nB; ++ui;
        if (wr == 1) PG8_BAR;
    }
    PG8_WAIT_V(0);
    PG8_BAR;
#undef PG8_SA
#undef PG8_SB
#undef PG8_STAGE
#undef PG8_LDA
#undef PG8_LDB
#undef PG8_MMA
#undef PG8_WAIT_V
#undef PG8_WAIT_L
#undef PG8_BAR
#undef PG8_SCHED
}
}
using pg8::Unit;

struct Args { const float* in[16]; float* out; unsigned char* ws; int ph_lo, ph_hi, chk, pad; };

__device__ __forceinline__ void xcd_split(int L, int& xcd, int& w) { xcd = L & 7; w = L >> 3; }

struct SchedP1 {
    int c, G; const bf16_t *H, *WinT, *MemH, *WkvT; bf16_t *QKZ, *VAT, *VBT, *KMEM, *VMEMT; float* PART1;
    __device__ __forceinline__ bool next(int i, Unit& u) const {
        const int L = i * G + c; if (L >= 2720) return false;
        u.nt = 32; u.pitch = 4096u; u.st = nullptr;
        if (L < 2688) {
            int xcd, w; xcd_split(L, xcd, w);
            const int pm = 8 * xcd + (w & 7), jn = w >> 3;
            const char* hrow = (const char*)(H + (size_t)pm * 256 * DM); const char* wrow = (const char*)(WinT + (size_t)jn * 256 * DM);
            u.pm = pm; u.pn = jn;
            const bool sw = (jn == 8 || jn == 9 || (jn >= 28 && jn < 34));
            if (!sw) {
                u.A = hrow; u.B = wrow; u.ldc = QKZ_LD;
                int col, kind;
                if (jn < 8) { col = jn * 256; kind = 0; }
                else if (jn < 16) { col = 2048 + (jn - 10) * 256; kind = 1; }
                else if (jn < 28) { col = 3584 + (jn - 16) * 128; kind = 2; }
                else if (jn < 38) { col = 5120 + (jn - 34) * 256; kind = 0; }
                else { col = 6144 + (jn - 38) * 256; kind = 1; }
                u.kind = kind; u.O = QKZ + (size_t)pm * 256 * QKZ_LD + col;
            } else {
                u.A = wrow; u.B = hrow; u.ldc = M;
                if (jn < 10) { u.kind = 3; u.O = VAT + (size_t)(jn - 8) * 256 * M + pm * 256; }
                else { u.kind = 4; u.O = VBT + (size_t)(jn - 28) * 256 * M + pm * 256; u.st = PART1 + (size_t)pm * 256 * 24 + (jn - 28) * 4; }
            }
        } else {
            const int e = L - 2688; u.pm = 0; u.pn = 0;
            if (e < 16) { const int pm = e & 3, pn = e >> 2; u.A = (const char*)(MemH + (size_t)pm * 256 * DM); u.B = (const char*)(WkvT + (size_t)pn * 256 * DM);
                u.kind = 0; u.ldc = 1024; u.O = KMEM + (size_t)pm * 256 * 1024 + pn * 256; }
            else { const int e2 = e - 16, pa = e2 >> 2, pb = e2 & 3; u.A = (const char*)(WkvT + (size_t)(1024 + pa * 256) * DM); u.B = (const char*)(MemH + (size_t)pb * 256 * DM);
                u.kind = 3; u.ldc = 1024; u.O = VMEMT + (size_t)pa * 256 * 1024 + pb * 256; }
        }
        return true;
    }
};
struct EpiP1 {
    __device__ __forceinline__ void operator()(const f32x4 (&acc)[2][2][4][2], const Unit& u, int wr, int wc, int fr, int fq) const {
        bf16_t* base = u.O + (size_t)(wr * 64 + fr) * u.ldc + wc * 32 + 8 * fq;
        const int kind = u.kind; const size_t ldc = (size_t)u.ldc;
        if (kind == 2) {
#pragma unroll
            for (int ai = 0; ai < 2; ++ai)
#pragma unroll
                for (int m = 0; m < 4; ++m) {
                    const f32x4 g0 = gelu4(acc[ai][0][m][0]), g1 = gelu4(acc[ai][0][m][1]), s0 = silu4(acc[ai][1][m][0]), s1 = silu4(acc[ai][1][m][1]);
                    *(u32x4*)(base + (size_t)(ai * 128 + m * 16) * ldc) = pack8(g0 * s0, g1 * s1);
                    asm volatile("" ::: "memory");
                }
        } else if (kind == 4) {
#pragma unroll
            for (int bj = 0; bj < 2; ++bj) {
                f32x4 s0 = (f32x4){0.f, 0.f, 0.f, 0.f}, s1 = s0, q0 = s0, q1 = s0;
#pragma unroll
                for (int ai = 0; ai < 2; ++ai)
#pragma unroll
                    for (int m = 0; m < 4; ++m) {
                        const f32x4 v0 = gelu4(acc[ai][bj][m][0]), v1 = gelu4(acc[ai][bj][m][1]);
                        s0 += v0; s1 += v1; q0 += v0 * v0; q1 += v1 * v1;
                        *(u32x4*)(base + (size_t)(ai * 128 + m * 16) * ldc + bj * 128) = pack8(v0, v1);
                        asm volatile("" ::: "memory");
                    }
#pragma unroll
                for (int n = 0; n < 2; ++n)
#pragma unroll
                    for (int j = 0; j < 4; ++j) {
                        float a = n ? s1[j] : s0[j], b = n ? q1[j] : q0[j];
#pragma unroll
                        for (int o = 1; o < 16; o <<= 1) { a += __shfl_xor(a, o); b += __shfl_xor(b, o); }
                        if (fr == 0) *(f32x2*)(u.st + (size_t)(bj * 128 + wc * 32 + 8 * fq + 4 * n + j) * 24 + wr * 2) = (f32x2){a, b};
                    }
                asm volatile("" ::: "memory");
            }
        } else {
            const bool act = (kind == 1);
#pragma unroll
            for (int ai = 0; ai < 2; ++ai)
#pragma unroll
                for (int m = 0; m < 4; ++m)
#pragma unroll
                    for (int bj = 0; bj < 2; ++bj) {
                        f32x4 v0 = acc[ai][bj][m][0], v1 = acc[ai][bj][m][1];
                        if (act) { v0 = silu4(v0); v1 = silu4(v1); }
                        *(u32x4*)(base + (size_t)(ai * 128 + m * 16) * ldc + bj * 128) = pack8(v0, v1);
                    }
        }
    }
};

struct SchedP3 {
    int c, G; const bf16_t *H, *WinT, *OBp, *WbrT; bf16_t* MERGED;
    __device__ __forceinline__ bool next(int i, Unit& u) const {
        const int T = (i / 6) * G + c, sub = i % 6; if (T >= 512) return false;
        int xcd, w; xcd_split(T, xcd, w);
        const int pm = 8 * xcd + (w & 7), pn = w >> 3, br = sub >> 1;
        u.pm = pm; u.pn = pn; u.st = nullptr; u.ldc = DM; u.O = MERGED + (size_t)pm * 256 * DM + pn * 256;
        if ((sub & 1) == 0) { u.kind = 0; u.nt = 32; u.pitch = 4096u; u.A = (const char*)(H + (size_t)pm * 256 * DM); u.B = (const char*)(WinT + (size_t)(10752 + br * 2048 + pn * 256) * DM); }
        else { const int koff = br * 1536; u.kind = 1 + br; u.nt = (br == 2) ? 16 : 24; u.pitch = 8192u;
            u.A = (const char*)(OBp + (size_t)pm * 256 * OB_LD + koff); u.B = (const char*)(WbrT + (size_t)pn * 256 * OB_LD + koff); }
        return true;
    }
};
struct EpiP3 {
    const char* sgb; const char* smb;
    template <int KIND>
    __device__ __forceinline__ void run(const f32x4 (&acc)[2][2][4][2], const Unit& u, int wr, int wc, int fr, int fq) const {
        char* gw_ = const_cast<char*>(sgb) + (threadIdx.x >> 6) * 16384 + (threadIdx.x & 63) * 16;
        char* mw_ = const_cast<char*>(smb) + (threadIdx.x >> 6) * 32768 + (threadIdx.x & 63) * 16;
        asm volatile("" : "+v"(gw_), "+v"(mw_));
#pragma unroll
        for (int ai = 0; ai < 2; ++ai)
#pragma unroll
            for (int bj = 0; bj < 2; ++bj)
#pragma unroll
                for (int m = 0; m < 4; ++m) {
                    const int idx = (ai * 2 + bj) * 4 + m;
                    GAS u32x4* gp = (GAS u32x4*)(gw_ + idx * 1024);
                    GAS f32x4* m0 = (GAS f32x4*)(mw_ + (idx * 2) * 1024); GAS f32x4* m1 = (GAS f32x4*)(mw_ + (idx * 2 + 1) * 1024);
                    if (KIND == 0) { *gp = pack8(sigmoid4(acc[ai][bj][m][0]), sigmoid4(acc[ai][bj][m][1])); }
                    else {
                        const u32x4 w = *gp;
                        f32x4 v0 = acc[ai][bj][m][0] * (f32x4){bf_lo(w.x), bf_hi(w.x), bf_lo(w.y), bf_hi(w.y)};
                        f32x4 v1 = acc[ai][bj][m][1] * (f32x4){bf_lo(w.z), bf_hi(w.z), bf_lo(w.w), bf_hi(w.w)};
                        if (KIND >= 2) { v0 += *m0; v1 += *m1; }
                        if (KIND <= 2) { *m0 = v0; *m1 = v1; }
                        else { bf16_t* base = u.O + (size_t)(wr * 64 + fr) * DM + wc * 32 + 8 * fq; *(u32x4*)(base + (size_t)(ai * 128 + m * 16) * DM + bj * 128) = pack8(v0, v1); }
                    }
                    asm volatile("" ::: "memory");
                }
    }
    __device__ __forceinline__ void operator()(const f32x4 (&acc)[2][2][4][2], const Unit& u, int wr, int wc, int fr, int fq) const {
        const int kind = u.kind;
        if (kind == 0) run<0>(acc, u, wr, wc, fr, fq); else if (kind == 1) run<1>(acc, u, wr, wc, fr, fq); else if (kind == 2) run<2>(acc, u, wr, wc, fr, fq); else run<3>(acc, u, wr, wc, fr, fq);
    }
};

struct SchedP4 {
    int c, G; const bf16_t *MERGED, *WoutT;
    __device__ __forceinline__ bool next(int i, Unit& u) const {
        const int T = i * G + c; if (T >= 512) return false;
        int xcd, w; xcd_split(T, xcd, w);
        const int pm = 8 * xcd + (w & 7), pn = w >> 3;
        u.pm = pm; u.pn = pn; u.st = nullptr; u.ldc = DM; u.O = nullptr; u.kind = 0; u.nt = 32; u.pitch = 4096u;
        u.A = (const char*)(MERGED + (size_t)pm * 256 * DM); u.B = (const char*)(WoutT + (size_t)pn * 256 * DM);
        return true;
    }
};
struct EpiP4 {
    bf16_t* delta;
    __device__ __forceinline__ void operator()(const f32x4 (&acc)[2][2][4][2], const Unit& u, int wr, int wc, int fr, int fq) const {
        bf16_t* base = delta + (size_t)(u.pm * 256 + wr * 64 + fr) * DM + u.pn * 256 + wc * 32 + 8 * fq;
#pragma unroll
        for (int ai = 0; ai < 2; ++ai)
#pragma unroll
            for (int m = 0; m < 4; ++m)
#pragma unroll
                for (int bj = 0; bj < 2; ++bj) *(u32x4*)(base + (size_t)(ai * 128 + m * 16) * DM + bj * 128) = pack8(acc[ai][bj][m][0], acc[ai][bj][m][1]);
    }
};

__device__ __forceinline__ int map_in(int n) {
    if (n < 4096 || n >= 8704) return n;
    if (n < 5632) { const int j = (n - 4096) >> 7, r = (n - 4096) & 127; return 4096 + 256 * j + r; }
    if (n < 7168) return 7168 + (n - 5632);
    { const int j = (n - 7168) >> 7, r = (n - 7168) & 127; return 4096 + 256 * j + 128 + r; }
}
__device__ __forceinline__ void p0_transpose_item(const float* W, int N, bf16_t* WT, int ldt, int koff, bool remap, LAS float* scr, int item, int lane) {
    const int nblk = N / 32, kb = item / nblk, nb = item % nblk, k0 = 64 * kb, n0 = 32 * nb;
#pragma unroll 8
    for (int i = 0; i < 32; ++i) { const int kk = 2 * i + (lane >> 5); scr[kk * 33 + (lane & 31)] = W[(size_t)(k0 + kk) * N + n0 + (lane & 31)]; }
    asm volatile("s_waitcnt lgkmcnt(0)" ::: "memory");
    const int c = lane & 7; const int d0 = remap ? map_in(n0) : n0;
#pragma unroll
    for (int j = 0; j < 4; ++j) { const int n = (lane >> 3) + 8 * j; const LAS float* s = scr + (8 * c) * 33 + n;
        u32x4 o; o.x = cvt_pk_bf16(s[0 * 33], s[1 * 33]); o.y = cvt_pk_bf16(s[2 * 33], s[3 * 33]); o.z = cvt_pk_bf16(s[4 * 33], s[5 * 33]); o.w = cvt_pk_bf16(s[6 * 33], s[7 * 33]);
        *(u32x4*)(WT + (size_t)(d0 + n) * ldt + koff + k0 + 8 * c) = o; }
    asm volatile("s_waitcnt lgkmcnt(0)" ::: "memory");
}
struct P0Job { const float* W; bf16_t* WT; int N, ldt, koff, k0, n0, d0; };
__device__ __forceinline__ void p0t_load(const P0Job& j, int tid, f32x4 (&v)[8]) {
#pragma unroll
    for (int i = 0; i < 8; ++i) { const int chunk = tid + 512 * i, k = chunk >> 5, cc = chunk & 31; v[i] = __builtin_nontemporal_load((const f32x4*)(j.W + (size_t)(j.k0 + k) * j.N + j.n0 + cc * 4)); }
}
__device__ __forceinline__ void p0t_store(const P0Job& j, int tid, const f32x4 (&v)[8], LAS float* scr) {
    __syncthreads();
#pragma unroll
    for (int i = 0; i < 8; ++i) { const int chunk = tid + 512 * i, k = chunk >> 5, cc = chunk & 31; LAS float* d = scr + k * 129 + cc * 4; d[0] = v[i][0]; d[1] = v[i][1]; d[2] = v[i][2]; d[3] = v[i][3]; }
    __syncthreads();
#pragma unroll
    for (int i = 0; i < 4; ++i) {
        const int chunk = tid + 512 * i, n = (chunk & 15) + 16 * (chunk >> 8), c = (chunk >> 4) & 15;
        const LAS float* sp = scr + (8 * c) * 129 + n;
        u32x4 o; o.x = cvt_pk_bf16(sp[0 * 129], sp[1 * 129]); o.y = cvt_pk_bf16(sp[2 * 129], sp[3 * 129]); o.z = cvt_pk_bf16(sp[4 * 129], sp[5 * 129]); o.w = cvt_pk_bf16(sp[6 * 129], sp[7 * 129]);
        *(u32x4*)(j.WT + (size_t)(j.d0 + n) * j.ldt + j.koff + j.k0 + 8 * c) = o;
    }
}
__device__ __forceinline__ void rms_2rows_to_bf16(const float* xrow0, const float* xrow1, const float* gain, bf16_t* orow0, bf16_t* orow1, int lane) {
    const f32x4* x0 = (const f32x4*)xrow0 + lane; const f32x4* x1 = (const f32x4*)xrow1 + lane; const f32x4* gr = (const f32x4*)gain + lane;
    f32x4 v0[8], v1[8]; float s0 = 0.f, s1 = 0.f;
#pragma unroll
    for (int j = 0; j < 8; ++j) { v0[j] = __builtin_nontemporal_load(x0 + 64 * j); v1[j] = __builtin_nontemporal_load(x1 + 64 * j); }
#pragma unroll
    for (int j = 0; j < 8; ++j) { s0 += (v0[j][0] * v0[j][0] + v0[j][1] * v0[j][1]) + (v0[j][2] * v0[j][2] + v0[j][3] * v0[j][3]); s1 += (v1[j][0] * v1[j][0] + v1[j][1] * v1[j][1]) + (v1[j][2] * v1[j][2] + v1[j][3] * v1[j][3]); }
    const float r0 = 1.0f / sqrtf(wave_sum(s0) * (1.f / DM) + EPS), r1 = 1.0f / sqrtf(wave_sum(s1) * (1.f / DM) + EPS);
    u32x2* o0 = (u32x2*)orow0 + lane; u32x2* o1 = (u32x2*)orow1 + lane;
#pragma unroll
    for (int j = 0; j < 8; ++j) { const f32x4 g = gr[64 * j]; const f32x4 y0 = v0[j] * r0 * g, y1 = v1[j] * r1 * g;
        o0[64 * j] = (u32x2){cvt_pk_bf16(y0[0], y0[1]), cvt_pk_bf16(y0[2], y0[3])}; o1[64 * j] = (u32x2){cvt_pk_bf16(y1[0], y1[1]), cvt_pk_bf16(y1[2], y1[3])}; }
}
template <int NR>
__device__ __forceinline__ void rms_rows_to_bf16(const float* xrow, const float* gain, bf16_t* orow, int lane) {
    const f32x4* gr = (const f32x4*)gain + lane;
    f32x4 v[NR][8]; float s[NR];
#pragma unroll
    for (int q = 0; q < NR; ++q) { const f32x4* xq = (const f32x4*)(xrow + (size_t)q * DM) + lane;
#pragma unroll
        for (int j = 0; j < 8; ++j) v[q][j] = __builtin_nontemporal_load(xq + 64 * j); }
#pragma unroll
    for (int q = 0; q < NR; ++q) { float t = 0.f;
#pragma unroll
        for (int j = 0; j < 8; ++j) t += (v[q][j][0] * v[q][j][0] + v[q][j][1] * v[q][j][1]) + (v[q][j][2] * v[q][j][2] + v[q][j][3] * v[q][j][3]);
        s[q] = 1.0f / sqrtf(wave_sum(t) * (1.f / DM) + EPS); }
#pragma unroll
    for (int q = 0; q < NR; ++q) { u32x2* o = (u32x2*)(orow + (size_t)q * DM) + lane;
#pragma unroll
        for (int j = 0; j < 8; ++j) { const f32x4 y = v[q][j] * s[q] * gr[64 * j]; o[64 * j] = (u32x2){cvt_pk_bf16(y[0], y[1]), cvt_pk_bf16(y[2], y[3])}; } }
}
__device__ __forceinline__ void rms_row_to_bf16(const float* xrow, const float* gain, bf16_t* orow, int lane) {
    const f32x4* xr = (const f32x4*)xrow + lane; const f32x4* gr = (const f32x4*)gain + lane;
    f32x4 v[8]; float s = 0.f;
#pragma unroll
    for (int j = 0; j < 8; ++j) { v[j] = xr[64 * j]; s += (v[j][0] * v[j][0] + v[j][1] * v[j][1]) + (v[j][2] * v[j][2] + v[j][3] * v[j][3]); }
    const float rstd = 1.0f / sqrtf(wave_sum(s) * (1.f / DM) + EPS);
    u32x2* o8 = (u32x2*)orow + lane;
#pragma unroll
    for (int j = 0; j < 8; ++j) { const f32x4 g = gr[64 * j]; const f32x4 y = v[j] * rstd * g; o8[64 * j] = (u32x2){cvt_pk_bf16(y[0], y[1]), cvt_pk_bf16(y[2], y[3])}; }
}


struct P0W { const float *w_in, *w_kv, *w_bra, *w_brb, *w_brc, *w_out; bf16_t *WinT, *WkvT, *WbrT, *WoutT; };
__device__ __forceinline__ void p0_mk(const P0W& p, int set, int it, P0Job& j) {
    constexpr int KB = DM / 128, NIN = N_IN / 128, NG0 = 84, T_KV = KB * (DM / 128), T_A = (1536 / 128) * (DM / 128), T_C = (1024 / 128) * (DM / 128);
    int r = it; const float* W; bf16_t* WT; int N = DM, ldt = DM, koff = 0, kb, nb; bool remap = false;
    const int n_in = (set == 0) ? KB * NG0 : (set == 1) ? KB * (NIN - NG0) : KB * NIN, ncol = (set == 0) ? NG0 : (set == 1) ? (NIN - NG0) : NIN, col0 = (set == 1) ? NG0 : 0;
    bool found = false;
    if (r < n_in) { W = p.w_in; WT = p.WinT; N = N_IN; remap = true; kb = r / ncol; nb = col0 + r % ncol; found = true; }
    else r -= n_in;
    if (!found && set != 1) { if (r < T_KV) { W = p.w_kv; WT = p.WkvT; kb = r / 16; nb = r % 16; found = true; } else r -= T_KV; }
    if (!found) {
        if (r < T_A) { W = p.w_bra; WT = p.WbrT; ldt = OB_LD; koff = 0; }
        else if ((r -= T_A) < T_A) { W = p.w_brb; WT = p.WbrT; ldt = OB_LD; koff = 1536; }
        else if ((r -= T_A) < T_C) { W = p.w_brc; WT = p.WbrT; ldt = OB_LD; koff = 3072; }
        else { r -= T_C; W = p.w_out; WT = p.WoutT; }
        kb = r / 16; nb = r % 16;
    }
    j.W = W; j.WT = WT; j.N = N; j.ldt = ldt; j.koff = koff; j.k0 = 128 * kb; j.n0 = 128 * nb; j.d0 = remap ? map_in(128 * nb) : 128 * nb;
}
__host__ __device__ constexpr int p0_count(int set) {
    constexpr int KB = DM / 128, NIN = N_IN / 128, NG0 = 84, T_KV = KB * (DM / 128), REST = 2 * (1536 / 128) * (DM / 128) + (1024 / 128) * (DM / 128) + T_KV;
    return set == 0 ? KB * NG0 + T_KV : set == 1 ? KB * (NIN - NG0) + REST : KB * NIN + T_KV + REST;
}
__device__ __forceinline__ void p0_tiles(const P0W& p, int set, int first, int stride, int tid, LAS float* scr) {
    const int NT = p0_count(set);
    f32x4 va[8], vb[8]; P0Job ja, jb;
    int it = first;
    if (it < NT) { p0_mk(p, set, it, ja); p0t_load(ja, tid, va); }
    while (it < NT) {
        const int it2 = it + stride; const bool h2 = it2 < NT;
        if (h2) { p0_mk(p, set, it2, jb); p0t_load(jb, tid, vb); }
        p0t_store(ja, tid, va, scr);
        it = it2; if (!h2) break;
        const int it3 = it + stride; const bool h3 = it3 < NT;
        if (h3) { p0_mk(p, set, it3, ja); p0t_load(ja, tid, va); }
        p0t_store(jb, tid, vb, scr);
        it = it3;
    }
    __syncthreads();
}

template <int DH, int NPAIR, int NACT, bool WIN>
__device__ __forceinline__ void attn_item(LAS unsigned char* lds, int tid, const bf16_t* qp, int ldq, const bf16_t* kp, int ldk, const bf16_t* vtp, int ldv,
                                          int lo, int hi, float slope2, float sink2, float qk2, const bf16_t* zp, int ldz, bf16_t* op, int ldo) {
    constexpr int NK = 32 * NPAIR, KROW = DH * 2 + 16, CPR = DH / 8, VROW = NK * 2 + 16, CPRV = NK / 8, NS = DH / 32, NDB = DH / 16;
    const int lane = tid & 63, w = __builtin_amdgcn_readfirstlane(tid >> 6), fr = lane & 15, fq = lane >> 4;
    const int g0 = WIN ? (w >> 1) : 0;
    __syncthreads();
    {
        constexpr int PER = NK * CPR / 512;
        constexpr int BT = (PER % 8 == 0) ? 8 : 6;
#pragma unroll 1
        for (int i0 = 0; i0 < PER; i0 += BT) {
            u32x4 v[BT];
#pragma unroll
            for (int i = 0; i < BT; ++i) {
                const int chunk = tid + 512 * (i0 + i), row = chunk / CPR, cc = chunk % CPR;
                int src = row; if (row < lo) src += 128; if (row >= hi) src -= 128;
                v[i] = *(const u32x4*)(kp + (long)src * ldk + cc * 8);
            }
#pragma unroll
            for (int i = 0; i < BT; ++i) {
                const int chunk = tid + 512 * (i0 + i), row = chunk / CPR, cc = chunk % CPR;
                const int k5 = row & 31, slot = (row & ~31) + 16 * ((k5 >> 2) & 1) + 4 * (k5 >> 3) + (k5 & 3);
                *(LAS u32x4*)(lds + slot * KROW + cc * 16) = v[i];
            }
            asm volatile("" ::: "memory");
        }
    }
    bf16x8 qf[NS];
#pragma unroll
    for (int s = 0; s < NS; ++s) qf[s] = *(const bf16x8*)(qp + (long)(16 * w + fr) * ldq + 32 * s + 8 * fq);
    constexpr bool ZPRE = WIN;
    u32x2 zpre[ZPRE ? NDB : 1];
    if (ZPRE) {
#pragma unroll
        for (int db = 0; db < NDB; ++db) zpre[db] = *(const u32x2*)(zp + (long)(16 * w + fr) * ldz + 16 * db + 4 * fq);
    }
    __syncthreads();
    f32x4 sc[NACT][2];
#pragma unroll
    for (int pi = 0; pi < NACT; ++pi)
#pragma unroll
        for (int blk = 0; blk < 2; ++blk) {
            f32x4 a = (f32x4){0.f, 0.f, 0.f, 0.f};
            const LAS unsigned char* kr = lds + (32 * (g0 + pi) + 16 * blk + fr) * KROW + fq * 16;
#pragma unroll
            for (int s = 0; s < NS; ++s) a = __builtin_amdgcn_mfma_f32_16x16x32_bf16(*(const LAS bf16x8*)(kr + s * 64), qf[s], a, 0, 0, 0);
            sc[pi][blk] = a;
        }
    const int tq = 16 * w + fr;
    float mx = -1e30f;
#pragma unroll
    for (int pi = 0; pi < NACT; ++pi)
#pragma unroll
        for (int blk = 0; blk < 2; ++blk)
#pragma unroll
            for (int r = 0; r < 4; ++r) {
                float v = sc[pi][blk][r] * qk2;
                if (WIN) { const int kk = 32 * (g0 + pi) + 8 * fq + 4 * blk + r; const int dist = abs(tq - (kk - 128));
                    v = v - slope2 * (float)dist; if (dist > 128 || kk < lo || kk >= hi) v = -1e30f; }
                sc[pi][blk][r] = v; mx = fmaxf(mx, v);
            }
    mx = fmaxf(mx, __shfl_xor(mx, 16)); mx = fmaxf(mx, __shfl_xor(mx, 32));
    if (WIN) mx = fmaxf(mx, sink2);
    float l = 0.f; bf16x8 pf[NACT];
#pragma unroll
    for (int pi = 0; pi < NACT; ++pi) {
        f32x4 p0, p1;
#pragma unroll
        for (int r = 0; r < 4; ++r) { p0[r] = __builtin_amdgcn_exp2f(sc[pi][0][r] - mx); p1[r] = __builtin_amdgcn_exp2f(sc[pi][1][r] - mx); }
        l += (p0[0] + p0[1]) + (p0[2] + p0[3]) + (p1[0] + p1[1]) + (p1[2] + p1[3]);
        const u32x4 pk = pack8(p0, p1); pf[pi] = __builtin_bit_cast(bf16x8, pk);
    }
    l += __shfl_xor(l, 16); l += __shfl_xor(l, 32);
    if (WIN) l += __builtin_amdgcn_exp2f(sink2 - mx);
    __syncthreads();
    {
        constexpr int PER = DH * CPRV / 512;
        constexpr int BT = (PER % 8 == 0) ? 8 : 6;
#pragma unroll 1
        for (int i0 = 0; i0 < PER; i0 += BT) {
            u32x4 v[BT];
#pragma unroll
            for (int i = 0; i < BT; ++i) {
                const int chunk = tid + 512 * (i0 + i), row = chunk / CPRV, cc = chunk % CPRV;
                int kk = cc * 8; if (kk < lo) kk += 128; if (kk >= hi) kk -= 128;
                v[i] = *(const u32x4*)(vtp + (long)row * ldv + kk);
            }
#pragma unroll
            for (int i = 0; i < BT; ++i) { const int chunk = tid + 512 * (i0 + i), row = chunk / CPRV, cc = chunk % CPRV; *(LAS u32x4*)(lds + row * VROW + cc * 16) = v[i]; }
            asm volatile("" ::: "memory");
        }
    }
    __syncthreads();
    const float inv = 1.0f / l;
#pragma unroll
    for (int db = 0; db < NDB; ++db) {
        f32x4 o = (f32x4){0.f, 0.f, 0.f, 0.f};
        const LAS unsigned char* vr = lds + (16 * db + fr) * VROW + g0 * 64 + fq * 16;
#pragma unroll
        for (int pi = 0; pi < NACT; ++pi) o = __builtin_amdgcn_mfma_f32_16x16x32_bf16(*(const LAS bf16x8*)(vr + pi * 64), pf[pi], o, 0, 0, 0);
        const int d = 16 * db + 4 * fq;
        u32x2 z; if (ZPRE) z = zpre[db]; else z = *(const u32x2*)(zp + (long)tq * ldz + d);
        const float y0 = o[0] * inv * bf_lo(z.x), y1 = o[1] * inv * bf_hi(z.x), y2 = o[2] * inv * bf_lo(z.y), y3 = o[3] * inv * bf_hi(z.y);
        *(u32x2*)(op + (long)tq * ldo + d) = (u32x2){cvt_pk_bf16(y0, y1), cvt_pk_bf16(y2, y3)};
    }
}

template <int NG>
__device__ __forceinline__ void gate_item(LAS unsigned char* lds, int tid, int ck, int gbeg, const bf16_t* VBT, const float* PART1, const float* lng, const float* lnb,
                                          const float* wsp, const float* bsp, const bf16_t* QKZ, bf16_t* OBp) {
    constexpr int VROW = 272, BUF = 128 * VROW;
    const int lane = tid & 63, w = __builtin_amdgcn_readfirstlane(tid >> 6), fr = lane & 15, fq = lane >> 4;
    LAS float* mu = (LAS float*)(lds + 2 * BUF); LAS float* rs = mu + 128;
    const int t = 16 * w + fr; const size_t tok = (size_t)ck * 128 + t;
    __syncthreads();
    if (tid < 128) {
        const f32x4* pp = (const f32x4*)(PART1 + (size_t)(ck * 128 + tid) * 24); float s = 0.f, q = 0.f;
#pragma unroll
        for (int i = 0; i < 6; ++i) { const f32x4 v = pp[i]; s += v[0] + v[2]; q += v[1] + v[3]; }
        const float mean = s * (1.f / 1536.f), var = fmaxf(q * (1.f / 1536.f) - mean * mean, 0.f);
        mu[tid] = mean; rs[tid] = 1.0f / sqrtf(var + EPS);
    }
    u32x4 raw[4];
#pragma unroll
    for (int i = 0; i < 4; ++i) { const int chunk = tid + 512 * i, row = chunk >> 4, cc = chunk & 15; raw[i] = *(const u32x4*)(VBT + (size_t)(gbeg * 128 + row) * M + ck * 128 + cc * 8); }
    __syncthreads();
#pragma unroll 1
    for (int gi = 0; gi < NG; ++gi) {
        const int g = gbeg + gi; LAS unsigned char* buf = lds + (gi & 1) * BUF;
        f32x4 wa[4], wb[4];
        { const float* wp = wsp + ((size_t)g * 128 + t) * 128 + 8 * fq;
#pragma unroll
            for (int k = 0; k < 4; ++k) { wa[k] = *(const f32x4*)(wp + 32 * k); wb[k] = *(const f32x4*)(wp + 32 * k + 4); } }
        const float bs = bsp[g * 128 + t];
        u32x2 z[8];
#pragma unroll
        for (int cbk = 0; cbk < 8; ++cbk) z[cbk] = *(const u32x2*)(QKZ + tok * QKZ_LD + 3584 + g * 128 + 16 * cbk + 4 * fq);
#pragma unroll
        for (int i = 0; i < 4; ++i) {
            const int chunk = tid + 512 * i, row = chunk >> 4, cc = chunk & 15;
            const float ga = lng[g * 128 + row], be = lnb[g * 128 + row];
            const f32x4 m0 = *(const LAS f32x4*)(mu + cc * 8), m1 = *(const LAS f32x4*)(mu + cc * 8 + 4), r0 = *(const LAS f32x4*)(rs + cc * 8), r1 = *(const LAS f32x4*)(rs + cc * 8 + 4);
            const u32x4 x = raw[i];
            f32x4 a = (f32x4){bf_lo(x.x), bf_hi(x.x), bf_lo(x.y), bf_hi(x.y)}, b = (f32x4){bf_lo(x.z), bf_hi(x.z), bf_lo(x.w), bf_hi(x.w)};
            a = (a - m0) * r0 * ga + be; b = (b - m1) * r1 * ga + be;
            *(LAS u32x4*)(buf + row * VROW + cc * 16) = pack8(a, b);
        }
        if (gi + 1 < NG) {
#pragma unroll
            for (int i = 0; i < 4; ++i) { const int chunk = tid + 512 * i, row = chunk >> 4, cc = chunk & 15; raw[i] = *(const u32x4*)(VBT + (size_t)((g + 1) * 128 + row) * M + ck * 128 + cc * 8); }
        }
        __syncthreads();
        bf16x8 wf[4];
#pragma unroll
        for (int k = 0; k < 4; ++k) { const u32x4 pk = pack8(wa[k], wb[k]); wf[k] = __builtin_bit_cast(bf16x8, pk); }
#pragma unroll
        for (int cbk = 0; cbk < 8; ++cbk) {
            f32x4 o = (f32x4){0.f, 0.f, 0.f, 0.f};
            const LAS unsigned char* vr = buf + (16 * cbk + fr) * VROW + fq * 16;
#pragma unroll
            for (int k = 0; k < 4; ++k) o = __builtin_amdgcn_mfma_f32_16x16x32_bf16(*(const LAS bf16x8*)(vr + k * 64), wf[k], o, 0, 0, 0);
            const int ch = g * 128 + 16 * cbk + 4 * fq;
            const float y0 = (o[0] + bs) * bf_lo(z[cbk].x), y1 = (o[1] + bs) * bf_hi(z[cbk].x), y2 = (o[2] + bs) * bf_lo(z[cbk].y), y3 = (o[3] + bs) * bf_hi(z[cbk].y);
            *(u32x2*)(OBp + tok * OB_LD + 1536 + ch) = (u32x2){cvt_pk_bf16(y0, y1), cvt_pk_bf16(y2, y3)};
        }
    }
}

#define XB_TMO      128
#define XB_XCNT(j)  (256  + 64 * (j))
#define XB_XSUB(j)  (1280 + 64 * (j))
#define XB_XGEN(j)  (2304 + 64 * (j))
#define XB_TOP      3328
#define XB_TOPGEN   3392
#define XCD_BAR_WORDS 3456
#define XB_SPIN_CAP (1u << 22)
__device__ __forceinline__ unsigned xb_ld(unsigned* p)              { return __hip_atomic_load(p, __ATOMIC_RELAXED, __HIP_MEMORY_SCOPE_AGENT); }
__device__ __forceinline__ unsigned xb_add(unsigned* p, unsigned v) { return __hip_atomic_fetch_add(p, v, __ATOMIC_RELAXED, __HIP_MEMORY_SCOPE_AGENT); }
__device__ __forceinline__ unsigned xb_xcc_id() { return (unsigned)__builtin_amdgcn_s_getreg((3 << 11) | 20) & 0xFu; }
#define XB_SPIN(cond, bar) do { unsigned _sp = 0; while (cond) { __builtin_amdgcn_s_sleep(1); \
    if ((++_sp & 255u) == 0u) { if (xb_ld(&(bar)[XB_TMO])) break; if (_sp > XB_SPIN_CAP) { atomicAdd(&(bar)[XB_TMO], 1u); break; } } } } while (0)
struct XcdBarrier { unsigned* bar; unsigned x; volatile LAS unsigned* st; };
__device__ __forceinline__ XcdBarrier xcd_barrier_post(unsigned* bar, volatile LAS unsigned* st) {
    XcdBarrier b; b.bar = bar; b.x = xb_xcc_id(); b.st = st;
    if (threadIdx.x == 0) (void)xb_add(&bar[XB_XCNT(b.x)], 1u);
    return b;
}
__device__ __forceinline__ void xcd_barrier_complete(unsigned* bar, unsigned x, unsigned& nloc, unsigned& nx) {
    const unsigned G = gridDim.x * gridDim.y * gridDim.z;
    unsigned sum, cnt, mine, sp = 0u;
    for (;;) {
        sum = 0u; cnt = 0u; mine = 0u;
#pragma unroll
        for (unsigned j = 0; j < 16; ++j) { const unsigned c = xb_ld(&bar[XB_XCNT(j)]); sum += c; cnt += (c > 0u) ? 1u : 0u; mine = (j == x) ? c : mine; }
        if (sum == G) break;
        __builtin_amdgcn_s_sleep(1);
        if ((++sp & 255u) == 0u) { if (xb_ld(&bar[XB_TMO])) break; if (sp > XB_SPIN_CAP) { atomicAdd(&bar[XB_TMO], 1u); break; } }
    }
    nloc = mine > 0u ? mine : 1u; nx = cnt > 0u ? cnt : 1u;
}
__device__ __forceinline__ void xcd_barrier(const XcdBarrier& b) {
    asm volatile("s_waitcnt vmcnt(0)" ::: "memory");
    __syncthreads();
    if (threadIdx.x == 0) {
        unsigned* bar = b.bar;
        __builtin_amdgcn_s_waitcnt(0);
        unsigned nloc = b.st[0], nx = b.st[1];
        if (nloc == 0u) { xcd_barrier_complete(bar, b.x, nloc, nx); b.st[0] = nloc; b.st[1] = nx; }
        const unsigned old = xb_add(&bar[XB_XSUB(b.x)], 1u);
        const unsigned gen = old / nloc;
        if (old + 1u == (gen + 1u) * nloc) {
            __builtin_amdgcn_fence(__ATOMIC_RELEASE, "agent");
            asm volatile("s_waitcnt vmcnt(0)" ::: "memory");
            const unsigned og = xb_add(&bar[XB_TOP], 1u);
            const unsigned tg = og / nx;
            if (og + 1u == (tg + 1u) * nx) xb_add(&bar[XB_TOPGEN], 1u);
            else XB_SPIN(xb_ld(&bar[XB_TOPGEN]) == tg, bar);
            __builtin_amdgcn_fence(__ATOMIC_ACQUIRE, "agent");
            xb_add(&bar[XB_XGEN(b.x)], 1u);
            asm volatile("s_waitcnt vmcnt(0)" ::: "memory");
        } else {
            XB_SPIN(xb_ld(&bar[XB_XGEN(b.x)]) == gen, bar);
            __builtin_amdgcn_fence(__ATOMIC_ACQUIRE, "agent");
            asm volatile("s_waitcnt vmcnt(0)" ::: "memory");
        }
    }
    __syncthreads();
}

template <int TMASK>
__global__ void __launch_bounds__(NWAVES * 64, 2) fwd_mega_t(Args args) {
    extern __shared__ __attribute__((aligned(16))) unsigned char lds_raw[];
    LAS unsigned char* lds = (LAS unsigned char*)lds_raw;
    const int tid = threadIdx.x, lane = tid & 63, wave = __builtin_amdgcn_readfirstlane(tid >> 6);
    const int G = gridDim.x, bx = blockIdx.x;
    const int vcu = (G % 8 == 0) ? (bx % 8) * (G / 8) + bx / 8 : bx;
    unsigned char* ws = args.ws;
    const float* x = args.in[0]; const float* mem = args.in[1]; const float* norm_gain = args.in[2]; const float* mem_gain = args.in[3];
    const float* w_in = args.in[4]; const float* sink = args.in[5]; const float* ln_g = args.in[6]; const float* ln_b = args.in[7];
    const float* w_sp = args.in[8]; const float* b_sp = args.in[9]; const float* w_kv = args.in[10]; const float* w_bra = args.in[11];
    const float* w_brb = args.in[12]; const float* w_brc = args.in[13]; const float* w_out = args.in[14]; const float* fin_gain = args.in[15];
    bf16_t* WinT = (bf16_t*)(ws + WS_WINT); bf16_t* H = (bf16_t*)(ws + WS_H); bf16_t* WkvT = (bf16_t*)(ws + WS_WKVT); bf16_t* MemH = (bf16_t*)(ws + WS_MEMH);
    bf16_t* WbrT = (bf16_t*)(ws + WS_WBRT); bf16_t* WoutT = (bf16_t*)(ws + WS_WOUTT); bf16_t* QKZ = (bf16_t*)(ws + WS_QKZ); bf16_t* OBp = (bf16_t*)(ws + WS_OB);
    bf16_t* KMEM = (bf16_t*)(ws + WS_KMEM); bf16_t* VMEMT = (bf16_t*)(ws + WS_VMEMT); float* PART1 = (float*)(ws + WS_PART1); float* PART2 = (float*)(ws + WS_PART2);
    bf16_t* MERGED = (bf16_t*)(ws + WS_MERGED);
#if defined(CHK) && CHK == 1
    bf16_t* VAT = (bf16_t*)(ws + WS_OB); bf16_t* VBT = (bf16_t*)(ws + WS_OB + 16 * MiB);
#else
    bf16_t* VAT = (bf16_t*)((unsigned char*)args.out + DO_VAT); bf16_t* VBT = (bf16_t*)((unsigned char*)args.out + DO_VBT);
#endif
    const int lo = args.ph_lo, hi = args.ph_hi;
    const bool defer_w = (G == 256) && (hi - lo > 1);
#ifndef PH_MASK
#define PH_MASK 127
#endif
#define IN(k) ((((PH_MASK) >> (k)) & 1) && ((TMASK >> (k)) & 1) && lo <= (k) && (k) < hi)
    volatile LAS unsigned* MISC = (volatile LAS unsigned*)(lds + LDS_BYTES - 64);
    if (tid < 16) MISC[tid] = 0u;
    __syncthreads();
    XcdBarrier xbar; xbar.bar = (unsigned*)ws; xbar.x = 0; xbar.st = MISC;
    if (hi - lo > 1) xbar = xcd_barrier_post((unsigned*)ws, MISC);
    if (args.chk == 0x7fffffff) cg::this_grid().sync();
#define SEAM(k) do { if (IN(k) && IN((k) + 1)) xcd_barrier(xbar); } while (0)

    if (IN(0)) {
        const int gw = vcu * NWAVES + wave, NGW = G * NWAVES;
        p0_tiles(P0W{w_in, w_kv, w_bra, w_brb, w_brc, w_out, WinT, WkvT, WbrT, WoutT}, defer_w ? 0 : 2, vcu, G, tid, (LAS float*)lds);
        for (int m = 4 * gw; m < M; m += 4 * NGW)
            rms_rows_to_bf16<4>(x + (size_t)m * DM, norm_gain, H + (size_t)m * DM, lane);
        for (int m = gw; m < MM; m += NGW) rms_row_to_bf16(mem + (size_t)m * DM, mem_gain, MemH + (size_t)m * DM, lane);
    }
    SEAM(0);
    if (IN(1)) {
        SchedP1 S{bx, G, H, WinT, MemH, WkvT, QKZ, VAT, VBT, KMEM, VMEMT, PART1};
        EpiP1 E;
        pg8::gemm_phase<EpiP1, SchedP1>(lds, S, E);
        if (defer_w && bx >= 160) p0_tiles(P0W{w_in, w_kv, w_bra, w_brb, w_brc, w_out, WinT, WkvT, WbrT, WoutT}, 1, bx - 160, 96, tid, (LAS float*)lds);
    }
    SEAM(1);
    if (IN(2)) {
        for (int it = vcu; it < 2304; it += G) {
            if (it < 512) {
                const int bh = it >> 5, qt = it & 31, b = bh >> 2, hd = bh & 3; const size_t tok0 = (size_t)b * SEQ + qt * 128;
                attn_item<256, 8, 8, false>(lds, tid, QKZ + tok0 * QKZ_LD + 5120 + hd * 256, QKZ_LD, KMEM + (size_t)b * 256 * 1024 + hd * 256, 1024,
                                            VMEMT + (size_t)hd * 256 * 1024 + b * 256, 1024, 0, 256, 0.f, 0.f, LOG2E * 0.0625f,
                                            QKZ + tok0 * QKZ_LD + 6144 + hd * 256, QKZ_LD, OBp + tok0 * OB_LD + 3072 + hd * 256, OB_LD);
            } else if (it < 2048) {
                const int idx = it - 512, r = idx % 3, rest = idx / 3, n = rest & 31, bh = rest >> 5, b = bh >> 2, hkv = bh & 3, hq = hkv * 3 + r;
                const long tok0 = (long)b * SEQ + n * 128;
                const float slope = (hq < 8) ? __builtin_amdgcn_exp2f(-(float)(hq + 1)) : __builtin_amdgcn_exp2f(-((float)(hq - 8) + 0.5f));
                attn_item<128, 12, 9, true>(lds, tid, QKZ + tok0 * QKZ_LD + hq * 128, QKZ_LD, QKZ + (tok0 - 128) * QKZ_LD + 1536 + hkv * 128, QKZ_LD,
                                            VAT + (long)hkv * 128 * M + (tok0 - 128), M, (n == 0) ? 128 : 0, (n == 31) ? 256 : 384,
                                            slope * LOG2E, sink[hq] * LOG2E, LOG2E * 0.08838834764831845f,
                                            QKZ + tok0 * QKZ_LD + 2048 + hq * 128, QKZ_LD, OBp + tok0 * OB_LD + hq * 128, OB_LD);
            } else {
                const int idx = it - 2048, ck = idx >> 1, hf = idx & 1;
                gate_item<6>(lds, tid, ck, hf * 6, VBT, PART1, ln_g, ln_b, w_sp, b_sp, QKZ, OBp);
            }
        }
        __syncthreads();
    }
    SEAM(2);
    if (IN(3)) {
        SchedP3 S{bx, G, H, WinT, OBp, WbrT, MERGED};
        EpiP3 E{(const char*)(ws + WS_SG) + (size_t)bx * 16 * 8192, (const char*)(ws + WS_SM) + (size_t)bx * 32 * 8192};
#ifdef P3_ZFILL
        { GAS u32x4* gz = (GAS u32x4*)(E.sgb + (tid >> 6) * 16384 + (tid & 63) * 16); GAS u32x4* mz = (GAS u32x4*)(E.smb + (tid >> 6) * 32768 + (tid & 63) * 16);
          for (int i = 0; i < 16; ++i) gz[i * 64] = (u32x4){0u, 0u, 0u, 0u};
          for (int i = 0; i < 32; ++i) mz[i * 64] = (u32x4){0u, 0u, 0u, 0u};
          asm volatile("s_waitcnt vmcnt(0)" ::: "memory"); __syncthreads(); }
#endif
        pg8::gemm_phase<EpiP3, SchedP3>(lds, S, E);
    }
    SEAM(3);
    if (IN(4)) {
        SchedP4 S{bx, G, MERGED, WoutT};
        EpiP4 E{(bf16_t*)(ws + WS_QKZ)};
        pg8::gemm_phase<EpiP4, SchedP4>(lds, S, E);
    }
    SEAM(4);
    if (IN(5)) {
        const int gw = vcu * NWAVES + wave, NGW = G * NWAVES;
        const bf16_t* DELTA = (const bf16_t*)(ws + WS_QKZ);
        const f32x4* gr = (const f32x4*)fin_gain + lane;
        for (int m0 = 2 * gw; m0 < M; m0 += 2 * NGW) {
            f32x4 v[2][8]; u32x2 d[2][8];
#pragma unroll
            for (int q = 0; q < 2; ++q) { const f32x4* xr = (const f32x4*)(x + (size_t)(m0 + q) * DM) + lane; const u32x2* dr = (const u32x2*)(DELTA + (size_t)(m0 + q) * DM) + lane;
#pragma unroll
                for (int j = 0; j < 8; ++j) { v[q][j] = __builtin_nontemporal_load(xr + 64 * j); d[q][j] = dr[64 * j]; } }
#pragma unroll
            for (int q = 0; q < 2; ++q) {
                float t = 0.f;
#pragma unroll
                for (int j = 0; j < 8; ++j) { v[q][j] += (f32x4){bf_lo(d[q][j].x), bf_hi(d[q][j].x), bf_lo(d[q][j].y), bf_hi(d[q][j].y)};
                    t += (v[q][j][0] * v[q][j][0] + v[q][j][1] * v[q][j][1]) + (v[q][j][2] * v[q][j][2] + v[q][j][3] * v[q][j][3]); }
                const float rstd = 1.0f / sqrtf(wave_sum(t) * (1.f / DM) + EPS);
                f32x4* o = (f32x4*)(args.out + (size_t)(m0 + q) * DM) + lane;
#pragma unroll
                for (int j = 0; j < 8; ++j) __builtin_nontemporal_store(v[q][j] * rstd * gr[64 * j], o + 64 * j);
            }
        }
    }
#ifdef CHK
    if (IN(6)) {
        const int gw = vcu * NWAVES + wave, NGW = G * NWAVES;
        for (int m = gw; m < M; m += NGW) {
            for (int c = lane; c < DM; c += 64) {
                float v = 0.f;
                if (args.chk == 2) v = bf_lo(OBp[(size_t)m * OB_LD + c]) + bf_lo(OBp[(size_t)m * OB_LD + 2048 + c]);
                else if (args.chk == 3) v = bf_lo(MERGED[(size_t)m * DM + c]);
                else if (args.chk == 1) { v = bf_lo(QKZ[(size_t)m * QKZ_LD + c]) + bf_lo(QKZ[(size_t)m * QKZ_LD + 2048 + c]) + bf_lo(QKZ[(size_t)m * QKZ_LD + 4096 + c]) + (c < 1024 ? bf_lo(QKZ[(size_t)m * QKZ_LD + 6144 + c]) : 0.f)
                        + bf_lo(VAT[(size_t)(c & 511) * M + m]) + bf_lo(VBT[(size_t)(c % 1536) * M + m]) + PART1[(size_t)m * 24 + (c % 24)] + bf_lo(KMEM[(size_t)(m & 1023) * 1024 + (c & 1023)]) + bf_lo(VMEMT[(size_t)(m & 1023) * 1024 + (c & 1023)]); }
                else if (args.chk == 0) v = bf_lo(H[(size_t)m * DM + c]) + bf_lo(WinT[(size_t)m * DM + c]) + bf_lo(WbrT[(size_t)(m & 2047) * OB_LD + c]) + bf_lo(WbrT[(size_t)(m & 2047) * OB_LD + 2048 + c]) + bf_lo(WoutT[(size_t)(m & 2047) * DM + c]) + bf_lo(WkvT[(size_t)(m & 2047) * DM + c]) + bf_lo(MemH[(size_t)(m & 1023) * DM + c]);
                args.out[(size_t)m * DM + c] = v;
            }
        }
    }
#endif
#undef IN
#undef SEAM
}

template <int P> static void launch_one(int grid, hipStream_t stream, const Args& a) {
    static bool init = false;
    if (!init) { (void)hipFuncSetAttribute((const void*)fwd_mega_t<(1 << P)>, hipFuncAttributeMaxDynamicSharedMemorySize, LDS_BYTES); init = true; }
    hipLaunchKernelGGL(fwd_mega_t<(1 << P)>, dim3(grid), dim3(NWAVES * 64), LDS_BYTES, stream, a);
}
static void launch_phase(int p, int grid, hipStream_t stream, const Args& a) {
    switch (p) { case 0: launch_one<0>(grid, stream, a); break; case 1: launch_one<1>(grid, stream, a); break; case 2: launch_one<2>(grid, stream, a); break;
                 case 3: launch_one<3>(grid, stream, a); break; case 4: launch_one<4>(grid, stream, a); break; case 5: launch_one<5>(grid, stream, a); break; default: launch_one<6>(grid, stream, a); break; }
}
extern "C" void kernel_launch(void* const* d_in, const int* in_sizes, int n_in, void* d_out, int out_size, void* d_ws, size_t ws_size, hipStream_t stream) {
    static int grid = 0;
    if (grid == 0) {
        if (n_in != 16 || in_sizes[0] != M * DM || out_size != M * DM || ws_size < WS_END) {
            fprintf(stderr, "kernel_launch: unexpected shapes / workspace (n_in %d, in0 %d, out %d, ws %zu < %zu); nothing launched\n", n_in, n_in > 0 ? in_sizes[0] : -1, out_size, ws_size, (size_t)WS_END);
            grid = -1; return; }
        int dev = 0, cus = 0, per_cu = 0;
        if (hipGetDevice(&dev) != hipSuccess || hipDeviceGetAttribute(&cus, hipDeviceAttributeMultiprocessorCount, dev) != hipSuccess) { grid = -1; return; }
        if (hipFuncSetAttribute((const void*)fwd_mega_t<127>, hipFuncAttributeMaxDynamicSharedMemorySize, LDS_BYTES) != hipSuccess) { fprintf(stderr, "kernel_launch: hipFuncSetAttribute failed\n"); grid = -1; return; }
        if (hipOccupancyMaxActiveBlocksPerMultiprocessor(&per_cu, (const void*)fwd_mega_t<127>, NWAVES * 64, LDS_BYTES) != hipSuccess || per_cu < 1) { fprintf(stderr, "kernel_launch: occupancy query says %d blocks per CU\n", per_cu); (void)hipGetLastError(); grid = -1; return; }
        grid = cus < 256 ? cus : 256;
    }
    if (grid < 0) return;
    Args a{};
    for (int i = 0; i < 16; ++i) a.in[i] = (const float*)d_in[i];
    a.out = (float*)d_out; a.ws = (unsigned char*)d_ws;
#ifdef CHK
    a.chk = CHK;
    for (int p = 0; p <= CHK; ++p) { a.ph_lo = p; a.ph_hi = p + 1; launch_phase(p, grid, stream, a); }
    a.ph_lo = 6; a.ph_hi = 7; launch_phase(6, grid, stream, a);
#elif MK_MULTI
    for (int p = 0; p < 6; ++p) { a.ph_lo = p; a.ph_hi = p + 1; launch_phase(p, grid, stream, a); }
#else
    a.ph_lo = 0; a.ph_hi = 6;
    if (hipMemsetAsync(d_ws, 0, 16384, stream) != hipSuccess) { fprintf(stderr, "kernel_launch: memset of barrier words failed\n"); return; }
    void* kargs[] = {&a};
    hipError_t e = hipLaunchCooperativeKernel((const void*)fwd_mega_t<127>, dim3(grid), dim3(NWAVES * 64), kargs, LDS_BYTES, stream);
    if (e != hipSuccess) fprintf(stderr, "kernel_launch: cooperative launch failed: %s (grid %d)\n", hipGetErrorString(e), grid);
#endif
}
```

```cpp
#include <hip/hip_runtime.h>
#include <hip/hip_cooperative_groups.h>
#include <cstdio>
#include <cstdint>
namespace cg = cooperative_groups;

#ifndef MK_MULTI
#define MK_MULTI 0
#endif

#define LAS __attribute__((address_space(3)))
#define GAS __attribute__((address_space(1)))
typedef unsigned short bf16_t;
typedef short bf16x8 __attribute__((ext_vector_type(8)));
typedef float f32x4 __attribute__((ext_vector_type(4)));
typedef float f32x2 __attribute__((ext_vector_type(2)));
typedef unsigned u32x4 __attribute__((ext_vector_type(4)));
typedef unsigned u32x2 __attribute__((ext_vector_type(2)));

constexpr int DM = 2048, NB = 4, SEQ = 4096, M = NB * SEQ, MEML = 256, MM = NB * MEML;
constexpr int N_IN = 16896;
constexpr int QKZ_LD = 7168;
constexpr int OB_LD = 4096;
constexpr float EPS = 1e-6f;
constexpr float LOG2E = 1.4426950408889634f;

constexpr size_t MiB = 1u << 20;
constexpr size_t WS_WINT = 1 * MiB;
constexpr size_t WS_H = 67 * MiB;
constexpr size_t WS_WKVT = 131 * MiB;
constexpr size_t WS_MEMH = 139 * MiB;
constexpr size_t WS_WBRT = 143 * MiB;
constexpr size_t WS_WOUTT = 159 * MiB;
constexpr size_t WS_QKZ = 167 * MiB;
constexpr size_t WS_SG = WS_QKZ, WS_SM = WS_QKZ + 32 * MiB, WS_MERGED = WS_QKZ + 96 * MiB;
constexpr size_t WS_OB = 391 * MiB;
constexpr size_t WS_KMEM = 519 * MiB;
constexpr size_t WS_VMEMT = 521 * MiB;
constexpr size_t WS_PART1 = 523 * MiB;
constexpr size_t WS_PART2 = 525 * MiB;
constexpr size_t WS_END = 527 * MiB;
constexpr size_t DO_VAT = 0, DO_VBT = 16 * MiB;

constexpr int LDS_BYTES = 147456;
constexpr int NWAVES = 8;

typedef __bf16 bf16x2_t __attribute__((ext_vector_type(2)));
__device__ __forceinline__ unsigned cvt_pk_bf16(float lo, float hi) { const f32x2 v = {lo, hi}; const bf16x2_t b = __builtin_convertvector(v, bf16x2_t); return __builtin_bit_cast(unsigned, b); }
__device__ __forceinline__ float bf_lo(unsigned w) { return __uint_as_float(w << 16); }
__device__ __forceinline__ float bf_hi(unsigned w) { return __uint_as_float(w & 0xffff0000u); }
__device__ __forceinline__ float sigmoidf_(float x) { return __builtin_amdgcn_rcpf(1.0f + __builtin_amdgcn_exp2f(-LOG2E * x)); }
__device__ __forceinline__ float siluf_(float x) { return x * sigmoidf_(x); }
__device__ __forceinline__ f32x4 silu4(f32x4 v) { return (f32x4){siluf_(v[0]), siluf_(v[1]), siluf_(v[2]), siluf_(v[3])}; }
__device__ __forceinline__ f32x4 sigmoid4(f32x4 v) { return (f32x4){sigmoidf_(v[0]), sigmoidf_(v[1]), sigmoidf_(v[2]), sigmoidf_(v[3])}; }
__device__ __forceinline__ f32x2 gelu_pk(f32x2 v) {
    const f32x2 av = __builtin_elementwise_abs(v), d = av * 0.2316418882f + 1.0f;
    f32x2 t; t.x = __builtin_amdgcn_rcpf(d.x); t.y = __builtin_amdgcn_rcpf(d.y);
    f32x2 q = t * 0.5307027145f + (-0.7265760135f); q = q * t + 0.7107068705f; q = q * t + (-0.142248368f); q = q * t + 0.127414796f; q = q * t;
    const f32x2 s = (v * v) * (-0.72134752044f);
    f32x2 e; e.x = __builtin_amdgcn_exp2f(s.x); e.y = __builtin_amdgcn_exp2f(s.y);
    const f32x2 m = v * (q * e), r = v - m;
    f32x2 o; o.x = v.x < 0.f ? m.x : r.x; o.y = v.y < 0.f ? m.y : r.y; return o;
}
__device__ __forceinline__ f32x4 gelu4(f32x4 v) { const f32x2 a = gelu_pk((f32x2){v[0], v[1]}), b = gelu_pk((f32x2){v[2], v[3]}); return (f32x4){a.x, a.y, b.x, b.y}; }
__device__ __forceinline__ u32x4 pack8(f32x4 a, f32x4 b) { u32x4 w; w.x = cvt_pk_bf16(a[0], a[1]); w.y = cvt_pk_bf16(a[2], a[3]); w.z = cvt_pk_bf16(b[0], b[1]); w.w = cvt_pk_bf16(b[2], b[3]); return w; }
__device__ __forceinline__ float wave_sum(float v) {
#pragma unroll
    for (int o = 1; o < 64; o <<= 1) v += __shfl_xor(v, o);
    return v;
}

namespace pg8 {
constexpr int BM = 256, BK = 64, HALF = 128, HTB = HALF * BK * 2, STAGE_BYTES = 8 * HTB;
__host__ __device__ __forceinline__ int lds_byte(int r, int c) { const int st = (r >> 4) * 2 + (c >> 5), rr = r & 15, cc = c & 31, ob = rr * 64 + cc * 2; return st * 1024 + (ob ^ (((ob >> 9) & 1) << 5)); }
__host__ __device__ __forceinline__ void stage_rc(int b, int& R, int& C) { const int st = b / 1024, sb = b % 1024, swz = sb ^ (((sb >> 9) & 1) << 5); R = (st >> 1) * 16 + swz / 64; C = (st & 1) * 32 + (swz % 64) / 2; }
__host__ __device__ __forceinline__ int perm32(int rho) { const int n = rho >> 4, i = rho & 15; return 8 * (i >> 2) + 4 * n + (i & 3); }

struct Unit { const char* A; const char* B; bf16_t* O; float* st; int nt; unsigned pitch; int ldc; int kind; int pm, pn; };

template <class Epi, class Sched>
__device__ __forceinline__ void gemm_phase(LAS unsigned char* lds, const Sched& S, const Epi& E) {
    const int tid = threadIdx.x, wid = __builtin_amdgcn_readfirstlane(tid >> 6), lane = tid & 63, wr = wid >> 2, wc = wid & 3, fr = lane & 15, fq = lane >> 4;
    unsigned rA, rB, cb;
    { int R, C; stage_rc(tid * 16, R, C); rA = (unsigned)R; rB = (unsigned)((R & ~31) + perm32(R & 31)); cb = (unsigned)C * 2u; }
    const unsigned ldsw = (unsigned)wid * 1024u;
    const int aoff = lds_byte(wr * 64 + fr, fq * 8), boff = lds_byte(wc * 32 + fr, fq * 8);
#define PG8_SA(b, h) (((b) * 2 + (h)) * HTB)
#define PG8_SB(b, h) ((4 + (b) * 2 + (h)) * HTB)
#define PG8_STAGE(bufoff, gbase, rr, pit) do { const unsigned o_ = (rr) * (pit) + cb; \
        __builtin_amdgcn_global_load_lds((const unsigned*)((const char*)(gbase) + o_), (LAS unsigned*)(lds + (bufoff) + ldsw), 16, 0, 0); \
        __builtin_amdgcn_global_load_lds((const unsigned*)((const char*)(gbase) + o_ + 64u * (pit)), (LAS unsigned*)(lds + (bufoff) + ldsw + 8192), 16, 0, 0); } while (0)
#define PG8_LDA(dst, b, h) do { _Pragma("unroll") for (int m = 0; m < 4; ++m) _Pragma("unroll") for (int k = 0; k < 2; ++k) dst[m][k] = *(const LAS bf16x8*)(lds + PG8_SA(b, h) + aoff + m * 2048 + k * 1024); } while (0)
#define PG8_LDB(dst, b, h) do { _Pragma("unroll") for (int n = 0; n < 2; ++n) _Pragma("unroll") for (int k = 0; k < 2; ++k) dst[n][k] = *(const LAS bf16x8*)(lds + PG8_SB(b, h) + boff + n * 2048 + k * 1024); } while (0)
#define PG8_MMA(ai, bj, At, Bt) do { __builtin_amdgcn_s_setprio(1); _Pragma("unroll") for (int m = 0; m < 4; ++m) _Pragma("unroll") for (int n = 0; n < 2; ++n) _Pragma("unroll") for (int k = 0; k < 2; ++k) \
        acc[ai][bj][m][n] = __builtin_amdgcn_mfma_f32_16x16x32_bf16(Bt[n][k], At[m][k], acc[ai][bj][m][n], 0, 0, 0); __builtin_amdgcn_s_setprio(0); } while (0)
#define PG8_WAIT_V(n) asm volatile("s_waitcnt vmcnt(" #n ")" ::: "memory")
#define PG8_WAIT_L(n) asm volatile("s_waitcnt lgkmcnt(" #n ")" ::: "memory")
#define PG8_BAR __builtin_amdgcn_s_barrier()
#define PG8_SCHED __builtin_amdgcn_sched_barrier(0)
    Unit cur, nxt; int ui = 0;
    if (!S.next(0, cur)) return;
    f32x4 acc[2][2][4][2];
#pragma unroll
    for (int a = 0; a < 2; ++a)
#pragma unroll
        for (int b = 0; b < 2; ++b)
#pragma unroll
            for (int m = 0; m < 4; ++m)
#pragma unroll
                for (int n = 0; n < 2; ++n) acc[a][b][m][n] = (f32x4){0.f, 0.f, 0.f, 0.f};
    bf16x8 At[4][2], B0[2][2], B1[2][2];
    const char* cA = cur.A; const char* cB = cur.B;
    const size_t kstep = (size_t)(BK * 2);
    {
        const unsigned pc = cur.pitch; const size_t hc = (size_t)HALF * pc;
        PG8_STAGE(PG8_SB(0, 0), cB, rB, pc); PG8_STAGE(PG8_SB(0, 1), cB + hc, rB, pc); PG8_STAGE(PG8_SA(0, 0), cA, rA, pc); PG8_STAGE(PG8_SA(0, 1), cA + hc, rA, pc);
        if (wr == 1) PG8_BAR;
        PG8_WAIT_V(2); PG8_BAR;
        PG8_STAGE(PG8_SB(1, 0), cB + kstep, rB, pc); PG8_STAGE(PG8_SA(1, 0), cA + kstep, rA, pc); PG8_STAGE(PG8_SB(1, 1), cB + hc + kstep, rB, pc);
        PG8_WAIT_V(6); PG8_BAR;
    }
    for (;;) {
        const bool has_next = S.next(ui + 1, nxt);
        const char* nA = has_next ? nxt.A : cA; const char* nB = has_next ? nxt.B : cB;
        const unsigned pc = cur.pitch, pnx = has_next ? nxt.pitch : cur.pitch; const size_t hc = (size_t)HALF * pc;
        const int nt = cur.nt;
        for (int t = 0; t < nt; t += 2) {
            const bool last = (t == nt - 2);
            const char* a1 = cA + (size_t)(t + 1) * kstep;
            const char* a2 = last ? nA : cA + (size_t)(t + 2) * kstep; const char* b2 = last ? nB : cB + (size_t)(t + 2) * kstep;
            const unsigned p2 = last ? pnx : pc; const size_t h2 = (size_t)HALF * p2;
            const char* a3 = a2 + kstep; const char* b3 = b2 + kstep;
            PG8_LDB(B0, 0, 0); PG8_LDB(B1, 0, 1); PG8_SCHED; PG8_LDA(At, 0, 0); PG8_STAGE(PG8_SA(1, 1), a1 + hc, rA, pc);
            PG8_WAIT_V(8); PG8_WAIT_L(0); PG8_BAR; PG8_MMA(0, 0, At, B0); PG8_MMA(0, 1, At, B1); PG8_BAR; PG8_SCHED;
            PG8_LDA(At, 0, 1); PG8_STAGE(PG8_SB(0, 0), b2, rB, p2); PG8_STAGE(PG8_SB(0, 1), b2 + h2, rB, p2); PG8_STAGE(PG8_SA(0, 0), a2, rA, p2);
            PG8_WAIT_V(8); PG8_WAIT_L(0); PG8_BAR; PG8_MMA(1, 0, At, B0); PG8_MMA(1, 1, At, B1); PG8_BAR; PG8_SCHED;
            PG8_LDB(B0, 1, 0); PG8_LDB(B1, 1, 1); PG8_SCHED; PG8_LDA(At, 1, 0); PG8_STAGE(PG8_SA(0, 1), a2 + h2, rA, p2);
            PG8_WAIT_V(8); PG8_WAIT_L(0); PG8_BAR; PG8_MMA(0, 0, At, B0); PG8_MMA(0, 1, At, B1); PG8_BAR; PG8_SCHED;
            PG8_LDA(At, 1, 1); PG8_STAGE(PG8_SB(1, 0), b3, rB, p2); PG8_STAGE(PG8_SB(1, 1), b3 + h2, rB, p2); PG8_STAGE(PG8_SA(1, 0), a3, rA, p2);
            PG8_WAIT_V(8); PG8_WAIT_L(0); PG8_BAR; PG8_MMA(1, 0, At, B0); PG8_MMA(1, 1, At, B1); PG8_BAR; PG8_SCHED;
        }
        if (wr == 0) PG8_BAR;
        E(acc, cur, wr, wc, fr, fq);
        if (!has_next) break;
#pragma unroll
        for (int a = 0; a < 2; ++a)
#pragma unroll
            for (int b = 0; b < 2; ++b)
#pragma unroll
                for (int m = 0; m < 4; ++m)
#pragma unroll
                    for (int n = 0; n < 2; ++n) acc[a][b][m][n] = (f32x4){0.f, 0.f, 0.f, 0.f};
        cur = nxt; cA = nA; cB = nB; ++ui;
        if (wr == 1) PG8_BAR;
    }
    PG8_WAIT_V(0);
    PG8_BAR;
#undef PG8_SA
#undef PG8_SB
#undef PG8_STAGE
#undef PG8_LDA
#undef PG8_LDB
#undef PG8_MMA
#undef PG8_WAIT_V
#undef PG8_WAIT_L
#undef PG8_BAR
#undef PG8_SCHED
}
}
using pg8::Unit;

struct Args { const float* in[16]; float* out; unsigned char* ws; int ph_lo, ph_hi, chk, pad; };

__device__ __forceinline__ void xcd_split(int L, int& xcd, int& w) { xcd = L & 7; w = L >> 3; }

struct SchedP1 {
    int c, G; const bf16_t *H, *WinT, *MemH, *WkvT; bf16_t *QKZ, *VAT, *VBT, *KMEM, *VMEMT; float* PART1;
    __device__ __forceinline__ bool next(int i, Unit& u) const {
        const int L = i * G + c; if (L >= 2720) return false;
        u.nt = 32; u.pitch = 4096u; u.st = nullptr;
        if (L < 2688) {
            int xcd, w; xcd_split(L, xcd, w);
            const int pm = 8 * xcd + (w & 7), jn = w >> 3;
            const char* hrow = (const char*)(H + (size_t)pm * 256 * DM); const char* wrow = (const char*)(WinT + (size_t)jn * 256 * DM);
            u.pm = pm; u.pn = jn;
            const bool sw = (jn == 8 || jn == 9 || (jn >= 28 && jn < 34));
            if (!sw) {
                u.A = hrow; u.B = wrow; u.ldc = QKZ_LD;
                int col, kind;
                if (jn < 8) { col = jn * 256; kind = 0; }
                else if (jn < 16) { col = 2048 + (jn - 10) * 256; kind = 1; }
                else if (jn < 28) { col = 3584 + (jn - 16) * 128; kind = 2; }
                else if (jn < 38) { col = 5120 + (jn - 34) * 256; kind = 0; }
                else { col = 6144 + (jn - 38) * 256; kind = 1; }
                u.kind = kind; u.O = QKZ + (size_t)pm * 256 * QKZ_LD + col;
            } else {
                u.A = wrow; u.B = hrow; u.ldc = M;
                if (jn < 10) { u.kind = 3; u.O = VAT + (size_t)(jn - 8) * 256 * M + pm * 256; }
                else { u.kind = 4; u.O = VBT + (size_t)(jn - 28) * 256 * M + pm * 256; u.st = PART1 + (size_t)pm * 256 * 24 + (jn - 28) * 4; }
            }
        } else {
            const int e = L - 2688; u.pm = 0; u.pn = 0;
            if (e < 16) { const int pm = e & 3, pn = e >> 2; u.A = (const char*)(MemH + (size_t)pm * 256 * DM); u.B = (const char*)(WkvT + (size_t)pn * 256 * DM);
                u.kind = 0; u.ldc = 1024; u.O = KMEM + (size_t)pm * 256 * 1024 + pn * 256; }
            else { const int e2 = e - 16, pa = e2 >> 2, pb = e2 & 3; u.A = (const char*)(WkvT + (size_t)(1024 + pa * 256) * DM); u.B = (const char*)(MemH + (size_t)pb * 256 * DM);
                u.kind = 3; u.ldc = 1024; u.O = VMEMT + (size_t)pa * 256 * 1024 + pb * 256; }
        }
        return true;
    }
};
struct EpiP1 {
    __device__ __forceinline__ void operator()(const f32x4 (&acc)[2][2][4][2], const Unit& u, int wr, int wc, int fr, int fq) const {
        bf16_t* base = u.O + (size_t)(wr * 64 + fr) * u.ldc + wc * 32 + 8 * fq;
        const int kind = u.kind; const size_t ldc = (size_t)u.ldc;
        if (kind == 2) {
#pragma unroll
            for (int ai = 0; ai < 2; ++ai)
#pragma unroll
                for (int m = 0; m < 4; ++m) {
                    const f32x4 g0 = gelu4(acc[ai][0][m][0]), g1 = gelu4(acc[ai][0][m][1]), s0 = silu4(acc[ai][1][m][0]), s1 = silu4(acc[ai][1][m][1]);
                    *(u32x4*)(base + (size_t)(ai * 128 + m * 16) * ldc) = pack8(g0 * s0, g1 * s1);
                    asm volatile("" ::: "memory");
                }
        } else if (kind == 4) {
#pragma unroll
            for (int bj = 0; bj < 2; ++bj) {
                f32x4 s0 = (f32x4){0.f, 0.f, 0.f, 0.f}, s1 = s0, q0 = s0, q1 = s0;
#pragma unroll
                for (int ai = 0; ai < 2; ++ai)
#pragma unroll
                    for (int m = 0; m < 4; ++m) {
                        const f32x4 v0 = gelu4(acc[ai][bj][m][0]), v1 = gelu4(acc[ai][bj][m][1]);
                        s0 += v0; s1 += v1; q0 += v0 * v0; q1 += v1 * v1;
                        *(u32x4*)(base + (size_t)(ai * 128 + m * 16) * ldc + bj * 128) = pack8(v0, v1);
                        asm volatile("" ::: "memory");
                    }
#pragma unroll
                for (int n = 0; n < 2; ++n)
#pragma unroll
                    for (int j = 0; j < 4; ++j) {
                        float a = n ? s1[j] : s0[j], b = n ? q1[j] : q0[j];
#pragma unroll
                        for (int o = 1; o < 16; o <<= 1) { a += __shfl_xor(a, o); b += __shfl_xor(b, o); }
                        if (fr == 0) *(f32x2*)(u.st + (size_t)(bj * 128 + wc * 32 + 8 * fq + 4 * n + j) * 24 + wr * 2) = (f32x2){a, b};
                    }
                asm volatile("" ::: "memory");
            }
        } else {
            const bool act = (kind == 1);
#pragma unroll
            for (int ai = 0; ai < 2; ++ai)
#pragma unroll
                for (int m = 0; m < 4; ++m)
#pragma unroll
                    for (int bj = 0; bj < 2; ++bj) {
                        f32x4 v0 = acc[ai][bj][m][0], v1 = acc[ai][bj][m][1];
                        if (act) { v0 = silu4(v0); v1 = silu4(v1); }
                        *(u32x4*)(base + (size_t)(ai * 128 + m * 16) * ldc + bj * 128) = pack8(v0, v1);
                    }
        }
    }
};

struct SchedP3 {
    int c, G; const bf16_t *H, *WinT, *OBp, *WbrT; bf16_t* MERGED;
    __device__ __forceinline__ bool next(int i, Unit& u) const {
        const int T = (i / 6) * G + c, sub = i % 6; if (T >= 512) return false;
        int xcd, w; xcd_split(T, xcd, w);
        const int pm = 8 * xcd + (w & 7), pn = w >> 3, br = sub >> 1;
        u.pm = pm; u.pn = pn; u.st = nullptr; u.ldc = DM; u.O = MERGED + (size_t)pm * 256 * DM + pn * 256;
        if ((sub & 1) == 0) { u.kind = 0; u.nt = 32; u.pitch = 4096u; u.A = (const char*)(H + (size_t)pm * 256 * DM); u.B = (const char*)(WinT + (size_t)(10752 + br * 2048 + pn * 256) * DM); }
        else { const int koff = br * 1536; u.kind = 1 + br; u.nt = (br == 2) ? 16 : 24; u.pitch = 8192u;
            u.A = (const char*)(OBp + (size_t)pm * 256 * OB_LD + koff); u.B = (const char*)(WbrT + (size_t)pn * 256 * OB_LD + koff); }
        return true;
    }
};
struct EpiP3 {
    const char* sgb; const char* smb;
    template <int KIND>
    __device__ __forceinline__ void run(const f32x4 (&acc)[2][2][4][2], const Unit& u, int wr, int wc, int fr, int fq) const {
        char* gw_ = const_cast<char*>(sgb) + (threadIdx.x >> 6) * 16384 + (threadIdx.x & 63) * 16;
        char* mw_ = const_cast<char*>(smb) + (threadIdx.x >> 6) * 32768 + (threadIdx.x & 63) * 16;
        asm volatile("" : "+v"(gw_), "+v"(mw_));
#pragma unroll
        for (int ai = 0; ai < 2; ++ai)
#pragma unroll
            for (int bj = 0; bj < 2; ++bj)
#pragma unroll
                for (int m = 0; m < 4; ++m) {
                    const int idx = (ai * 2 + bj) * 4 + m;
                    GAS u32x4* gp = (GAS u32x4*)(gw_ + idx * 1024);
                    GAS f32x4* m0 = (GAS f32x4*)(mw_ + (idx * 2) * 1024); GAS f32x4* m1 = (GAS f32x4*)(mw_ + (idx * 2 + 1) * 1024);
                    if (KIND == 0) { *gp = pack8(sigmoid4(acc[ai][bj][m][0]), sigmoid4(acc[ai][bj][m][1])); }
                    else {
                        const u32x4 w = *gp;
                        f32x4 v0 = acc[ai][bj][m][0] * (f32x4){bf_lo(w.x), bf_hi(w.x), bf_lo(w.y), bf_hi(w.y)};
                        f32x4 v1 = acc[ai][bj][m][1] * (f32x4){bf_lo(w.z), bf_hi(w.z), bf_lo(w.w), bf_hi(w.w)};
                        if (KIND >= 2) { v0 += *m0; v1 += *m1; }
                        if (KIND <= 2) { *m0 = v0; *m1 = v1; }
                        else { bf16_t* base = u.O + (size_t)(wr * 64 + fr) * DM + wc * 32 + 8 * fq; *(u32x4*)(base + (size_t)(ai * 128 + m * 16) * DM + bj * 128) = pack8(v0, v1); }
                    }
                    asm volatile("" ::: "memory");
                }
    }
    __device__ __forceinline__ void operator()(const f32x4 (&acc)[2][2][4][2], const Unit& u, int wr, int wc, int fr, int fq) const {
        const int kind = u.kind;
        if (kind == 0) run<0>(acc, u, wr, wc, fr, fq); else if (kind == 1) run<1>(acc, u, wr, wc, fr, fq); else if (kind == 2) run<2>(acc, u, wr, wc, fr, fq); else run<3>(acc, u, wr, wc, fr, fq);
    }
};

struct SchedP4 {
    int c, G; const bf16_t *MERGED, *WoutT;
    __device__ __forceinline__ bool next(int i, Unit& u) const {
        const int T = i * G + c; if (T >= 512) return false;
        int xcd, w; xcd_split(T, xcd, w);
        const int pm = 8 * xcd + (w & 7), pn = w >> 3;
        u.pm = pm; u.pn = pn; u.st = nullptr; u.ldc = DM; u.O = nullptr; u.kind = 0; u.nt = 32; u.pitch = 4096u;
        u.A = (const char*)(MERGED + (size_t)pm * 256 * DM); u.B = (const char*)(WoutT + (size_t)pn * 256 * DM);
        return true;
    }
};
struct EpiP4 {
    bf16_t* delta;
    __device__ __forceinline__ void operator()(const f32x4 (&acc)[2][2][4][2], const Unit& u, int wr, int wc, int fr, int fq) const {
        bf16_t* base = delta + (size_t)(u.pm * 256 + wr * 64 + fr) * DM + u.pn * 256 + wc * 32 + 8 * fq;
#pragma unroll
        for (int ai = 0; ai < 2; ++ai)
#pragma unroll
            for (int m = 0; m < 4; ++m)
#pragma unroll
                for (int bj = 0; bj < 2; ++bj) *(u32x4*)(base + (size_t)(ai * 128 + m * 16) * DM + bj * 128) = pack8(acc[ai][bj][m][0], acc[ai][bj][m][1]);
    }
};

__device__ __forceinline__ int map_in(int n) {
    if (n < 4096 || n >= 8704) return n;
    if (n < 5632) { const int j = (n - 4096) >> 7, r = (n - 4096) & 127; return 4096 + 256 * j + r; }
    if (n < 7168) return 7168 + (n - 5632);
    { const int j = (n - 7168) >> 7, r = (n - 7168) & 127; return 4096 + 256 * j + 128 + r; }
}
__device__ __forceinline__ void p0_transpose_item(const float* W, int N, bf16_t* WT, int ldt, int koff, bool remap, LAS float* scr, int item, int lane) {
    const int nblk = N / 32, kb = item / nblk, nb = item % nblk, k0 = 64 * kb, n0 = 32 * nb;
#pragma unroll 8
    for (int i = 0; i < 32; ++i) { const int kk = 2 * i + (lane >> 5); scr[kk * 33 + (lane & 31)] = W[(size_t)(k0 + kk) * N + n0 + (lane & 31)]; }
    asm volatile("s_waitcnt lgkmcnt(0)" ::: "memory");
    const int c = lane & 7; const int d0 = remap ? map_in(n0) : n0;
#pragma unroll
    for (int j = 0; j < 4; ++j) { const int n = (lane >> 3) + 8 * j; const LAS float* s = scr + (8 * c) * 33 + n;
        u32x4 o; o.x = cvt_pk_bf16(s[0 * 33], s[1 * 33]); o.y = cvt_pk_bf16(s[2 * 33], s[3 * 33]); o.z = cvt_pk_bf16(s[4 * 33], s[5 * 33]); o.w = cvt_pk_bf16(s[6 * 33], s[7 * 33]);
        *(u32x4*)(WT + (size_t)(d0 + n) * ldt + koff + k0 + 8 * c) = o; }
    asm volatile("s_waitcnt lgkmcnt(0)" ::: "memory");
}
struct P0Job { const float* W; bf16_t* WT; int N, ldt, koff, k0, n0, d0; };
__device__ __forceinline__ void p0t_load(const P0Job& j, int tid, f32x4 (&v)[8]) {
#pragma unroll
    for (int i = 0; i < 8; ++i) { const int chunk = tid + 512 * i, k = chunk >> 5, cc = chunk & 31; v[i] = __builtin_nontemporal_load((const f32x4*)(j.W + (size_t)(j.k0 + k) * j.N + j.n0 + cc * 4)); }
}
__device__ __forceinline__ void p0t_store(const P0Job& j, int tid, const f32x4 (&v)[8], LAS float* scr) {
    __syncthreads();
#pragma unroll
    for (int i = 0; i < 8; ++i) { const int chunk = tid + 512 * i, k = chunk >> 5, cc = chunk & 31; LAS float* d = scr + k * 129 + cc * 4; d[0] = v[i][0]; d[1] = v[i][1]; d[2] = v[i][2]; d[3] = v[i][3]; }
    __syncthreads();
#pragma unroll
    for (int i = 0; i < 4; ++i) {
        const int chunk = tid + 512 * i, n = (chunk & 15) + 16 * (chunk >> 8), c = (chunk >> 4) & 15;
        const LAS float* sp = scr + (8 * c) * 129 + n;
        u32x4 o; o.x = cvt_pk_bf16(sp[0 * 129], sp[1 * 129]); o.y = cvt_pk_bf16(sp[2 * 129], sp[3 * 129]); o.z = cvt_pk_bf16(sp[4 * 129], sp[5 * 129]); o.w = cvt_pk_bf16(sp[6 * 129], sp[7 * 129]);
        *(u32x4*)(j.WT + (size_t)(j.d0 + n) * j.ldt + j.koff + j.k0 + 8 * c) = o;
    }
}
__device__ __forceinline__ void rms_2rows_to_bf16(const float* xrow0, const float* xrow1, const float* gain, bf16_t* orow0, bf16_t* orow1, int lane) {
    const f32x4* x0 = (const f32x4*)xrow0 + lane; const f32x4* x1 = (const f32x4*)xrow1 + lane; const f32x4* gr = (const f32x4*)gain + lane;
    f32x4 v0[8], v1[8]; float s0 = 0.f, s1 = 0.f;
#pragma unroll
    for (int j = 0; j < 8; ++j) { v0[j] = __builtin_nontemporal_load(x0 + 64 * j); v1[j] = __builtin_nontemporal_load(x1 + 64 * j); }
#pragma unroll
    for (int j = 0; j < 8; ++j) { s0 += (v0[j][0] * v0[j][0] + v0[j][1] * v0[j][1]) + (v0[j][2] * v0[j][2] + v0[j][3] * v0[j][3]); s1 += (v1[j][0] * v1[j][0] + v1[j][1] * v1[j][1]) + (v1[j][2] * v1[j][2] + v1[j][3] * v1[j][3]); }
    const float r0 = 1.0f / sqrtf(wave_sum(s0) * (1.f / DM) + EPS), r1 = 1.0f / sqrtf(wave_sum(s1) * (1.f / DM) + EPS);
    u32x2* o0 = (u32x2*)orow0 + lane; u32x2* o1 = (u32x2*)orow1 + lane;
#pragma unroll
    for (int j = 0; j < 8; ++j) { const f32x4 g = gr[64 * j]; const f32x4 y0 = v0[j] * r0 * g, y1 = v1[j] * r1 * g;
        o0[64 * j] = (u32x2){cvt_pk_bf16(y0[0], y0[1]), cvt_pk_bf16(y0[2], y0[3])}; o1[64 * j] = (u32x2){cvt_pk_bf16(y1[0], y1[1]), cvt_pk_bf16(y1[2], y1[3])}; }
}
template <int NR>
__device__ __forceinline__ void rms_rows_to_bf16(const float* xrow, const float* gain, bf16_t* orow, int lane) {
    const f32x4* gr = (const f32x4*)gain + lane;
    f32x4 v[NR][8]; float s[NR];
#pragma unroll
    for (int q = 0; q < NR; ++q) { const f32x4* xq = (const f32x4*)(xrow + (size_t)q * DM) + lane;
#pragma unroll
        for (int j = 0; j < 8; ++j) v[q][j] = __builtin_nontemporal_load(xq + 64 * j); }
#pragma unroll
    for (int q = 0; q < NR; ++q) { float t = 0.f;
#pragma unroll
        for (int j = 0; j < 8; ++j) t += (v[q][j][0] * v[q][j][0] + v[q][j][1] * v[q][j][1]) + (v[q][j][2] * v[q][j][2] + v[q][j][3] * v[q][j][3]);
        s[q] = 1.0f / sqrtf(wave_sum(t) * (1.f / DM) + EPS); }
#pragma unroll
    for (int q = 0; q < NR; ++q) { u32x2* o = (u32x2*)(orow + (size_t)q * DM) + lane;
#pragma unroll
        for (int j = 0; j < 8; ++j) { const f32x4 y = v[q][j] * s[q] * gr[64 * j]; o[64 * j] = (u32x2){cvt_pk_bf16(y[0], y[1]), cvt_pk_bf16(y[2], y[3])}; } }
}
__device__ __forceinline__ void rms_row_to_bf16(const float* xrow, const float* gain, bf16_t* orow, int lane) {
    const f32x4* xr = (const f32x4*)xrow + lane; const f32x4* gr = (const f32x4*)gain + lane;
    f32x4 v[8]; float s = 0.f;
#pragma unroll
    for (int j = 0; j < 8; ++j) { v[j] = xr[64 * j]; s += (v[j][0] * v[j][0] + v[j][1] * v[j][1]) + (v[j][2] * v[j][2] + v[j][3] * v[j][3]); }
    const float rstd = 1.0f / sqrtf(wave_sum(s) * (1.f / DM) + EPS);
    u32x2* o8 = (u32x2*)orow + lane;
#pragma unroll
    for (int j = 0; j < 8; ++j) { const f32x4 g = gr[64 * j]; const f32x4 y = v[j] * rstd * g; o8[64 * j] = (u32x2){cvt_pk_bf16(y[0], y[1]), cvt_pk_bf16(y[2], y[3])}; }
}


struct P0W { const float *w_in, *w_kv, *w_bra, *w_brb, *w_brc, *w_out; bf16_t *WinT, *WkvT, *WbrT, *WoutT; };
__device__ __forceinline__ void p0_mk(const P0W& p, int set, int it, P0Job& j) {
    constexpr int KB = DM / 128, NIN = N_IN / 128, NG0 = 84, T_KV = KB * (DM / 128), T_A = (1536 / 128) * (DM / 128), T_C = (1024 / 128) * (DM / 128);
    int r = it; const float* W; bf16_t* WT; int N = DM, ldt = DM, koff = 0, kb, nb; bool remap = false;
    const int n_in = (set == 0) ? KB * NG0 : (set == 1) ? KB * (NIN - NG0) : KB * NIN, ncol = (set == 0) ? NG0 : (set == 1) ? (NIN - NG0) : NIN, col0 = (set == 1) ? NG0 : 0;
    bool found = false;
    if (r < n_in) { W = p.w_in; WT = p.WinT; N = N_IN; remap = true; kb = r / ncol; nb = col0 + r % ncol; found = true; }
    else r -= n_in;
    if (!found && set != 1) { if (r < T_KV) { W = p.w_kv; WT = p.WkvT; kb = r / 16; nb = r % 16; found = true; } else r -= T_KV; }
    if (!found) {
        if (r < T_A) { W = p.w_bra; WT = p.WbrT; ldt = OB_LD; koff = 0; }
        else if ((r -= T_A) < T_A) { W = p.w_brb; WT = p.WbrT; ldt = OB_LD; koff = 1536; }
        else if ((r -= T_A) < T_C) { W = p.w_brc; WT = p.WbrT; ldt = OB_LD; koff = 3072; }
        else { r -= T_C; W = p.w_out; WT = p.WoutT; }
        kb = r / 16; nb = r % 16;
    }
    j.W = W; j.WT = WT; j.N = N; j.ldt = ldt; j.koff = koff; j.k0 = 128 * kb; j.n0 = 128 * nb; j.d0 = remap ? map_in(128 * nb) : 128 * nb;
}
__host__ __device__ constexpr int p0_count(int set) {
    constexpr int KB = DM / 128, NIN = N_IN / 128, NG0 = 84, T_KV = KB * (DM / 128), REST = 2 * (1536 / 128) * (DM / 128) + (1024 / 128) * (DM / 128) + T_KV;
    return set == 0 ? KB * NG0 + T_KV : set == 1 ? KB * (NIN - NG0) + REST : KB * NIN + T_KV + REST;
}
__device__ __forceinline__ void p0_tiles(const P0W& p, int set, int first, int stride, int tid, LAS float* scr) {
    const int NT = p0_count(set);
    f32x4 va[8], vb[8]; P0Job ja, jb;
    int it = first;
    if (it < NT) { p0_mk(p, set, it, ja); p0t_load(ja, tid, va); }
    while (it < NT) {
        const int it2 = it + stride; const bool h2 = it2 < NT;
        if (h2) { p0_mk(p, set, it2, jb); p0t_load(jb, tid, vb); }
        p0t_store(ja, tid, va, scr);
        it = it2; if (!h2) break;
        const int it3 = it + stride; const bool h3 = it3 < NT;
        if (h3) { p0_mk(p, set, it3, ja); p0t_load(ja, tid, va); }
        p0t_store(jb, tid, vb, scr);
        it = it3;
    }
    __syncthreads();
}

template <int DH, int NPAIR, int NACT, bool WIN>
__device__ __forceinline__ void attn_item(LAS unsigned char* lds, int tid, const bf16_t* qp, int ldq, const bf16_t* kp, int ldk, const bf16_t* vtp, int ldv,
                                          int lo, int hi, float slope2, float sink2, float qk2, const bf16_t* zp, int ldz, bf16_t* op, int ldo) {
    constexpr int NK = 32 * NPAIR, KROW = DH * 2 + 16, CPR = DH / 8, VROW = NK * 2 + 16, CPRV = NK / 8, NS = DH / 32, NDB = DH / 16;
    const int lane = tid & 63, w = __builtin_amdgcn_readfirstlane(tid >> 6), fr = lane & 15, fq = lane >> 4;
    const int g0 = WIN ? (w >> 1) : 0;
    __syncthreads();
    {
        constexpr int PER = NK * CPR / 512;
        constexpr int BT = (PER % 8 == 0) ? 8 : 6;
#pragma unroll 1
        for (int i0 = 0; i0 < PER; i0 += BT) {
            u32x4 v[BT];
#pragma unroll
            for (int i = 0; i < BT; ++i) {
                const int chunk = tid + 512 * (i0 + i), row = chunk / CPR, cc = chunk % CPR;
                int src = row; if (row < lo) src += 128; if (row >= hi) src -= 128;
                v[i] = *(const u32x4*)(kp + (long)src * ldk + cc * 8);
            }
#pragma unroll
            for (int i = 0; i < BT; ++i) {
                const int chunk = tid + 512 * (i0 + i), row = chunk / CPR, cc = chunk % CPR;
                const int k5 = row & 31, slot = (row & ~31) + 16 * ((k5 >> 2) & 1) + 4 * (k5 >> 3) + (k5 & 3);
                *(LAS u32x4*)(lds + slot * KROW + cc * 16) = v[i];
            }
            asm volatile("" ::: "memory");
        }
    }
    bf16x8 qf[NS];
#pragma unroll
    for (int s = 0; s < NS; ++s) qf[s] = *(const bf16x8*)(qp + (long)(16 * w + fr) * ldq + 32 * s + 8 * fq);
    constexpr bool ZPRE = WIN;
    u32x2 zpre[ZPRE ? NDB : 1];
    if (ZPRE) {
#pragma unroll
        for (int db = 0; db < NDB; ++db) zpre[db] = *(const u32x2*)(zp + (long)(16 * w + fr) * ldz + 16 * db + 4 * fq);
    }
    __syncthreads();
    f32x4 sc[NACT][2];
#pragma unroll
    for (int pi = 0; pi < NACT; ++pi)
#pragma unroll
        for (int blk = 0; blk < 2; ++blk) {
            f32x4 a = (f32x4){0.f, 0.f, 0.f, 0.f};
            const LAS unsigned char* kr = lds + (32 * (g0 + pi) + 16 * blk + fr) * KROW + fq * 16;
#pragma unroll
            for (int s = 0; s < NS; ++s) a = __builtin_amdgcn_mfma_f32_16x16x32_bf16(*(const LAS bf16x8*)(kr + s * 64), qf[s], a, 0, 0, 0);
            sc[pi][blk] = a;
        }
    const int tq = 16 * w + fr;
    float mx = -1e30f;
#pragma unroll
    for (int pi = 0; pi < NACT; ++pi)
#pragma unroll
        for (int blk = 0; blk < 2; ++blk)
#pragma unroll
            for (int r = 0; r < 4; ++r) {
                float v = sc[pi][blk][r] * qk2;
                if (WIN) { const int kk = 32 * (g0 + pi) + 8 * fq + 4 * blk + r; const int dist = abs(tq - (kk - 128));
                    v = v - slope2 * (float)dist; if (dist > 128 || kk < lo || kk >= hi) v = -1e30f; }
                sc[pi][blk][r] = v; mx = fmaxf(mx, v);
            }
    mx = fmaxf(mx, __shfl_xor(mx, 16)); mx = fmaxf(mx, __shfl_xor(mx, 32));
    if (WIN) mx = fmaxf(mx, sink2);
    float l = 0.f; bf16x8 pf[NACT];
#pragma unroll
    for (int pi = 0; pi < NACT; ++pi) {
        f32x4 p0, p1;
#pragma unroll
        for (int r = 0; r < 4; ++r) { p0[r] = __builtin_amdgcn_exp2f(sc[pi][0][r] - mx); p1[r] = __builtin_amdgcn_exp2f(sc[pi][1][r] - mx); }
        l += (p0[0] + p0[1]) + (p0[2] + p0[3]) + (p1[0] + p1[1]) + (p1[2] + p1[3]);
        const u32x4 pk = pack8(p0, p1); pf[pi] = __builtin_bit_cast(bf16x8, pk);
    }
    l += __shfl_xor(l, 16); l += __shfl_xor(l, 32);
    if (WIN) l += __builtin_amdgcn_exp2f(sink2 - mx);
    __syncthreads();
    {
        constexpr int PER = DH * CPRV / 512;
        constexpr int BT = (PER % 8 == 0) ? 8 : 6;
#pragma unroll 1
        for (int i0 = 0; i0 < PER; i0 += BT) {
            u32x4 v[BT];
#pragma unroll
            for (int i = 0; i < BT; ++i) {
                const int chunk = tid + 512 * (i0 + i), row = chunk / CPRV, cc = chunk % CPRV;
                int kk = cc * 8; if (kk < lo) kk += 128; if (kk >= hi) kk -= 128;
                v[i] = *(const u32x4*)(vtp + (long)row * ldv + kk);
            }
#pragma unroll
            for (int i = 0; i < BT; ++i) { const int chunk = tid + 512 * (i0 + i), row = chunk / CPRV, cc = chunk % CPRV; *(LAS u32x4*)(lds + row * VROW + cc * 16) = v[i]; }
            asm volatile("" ::: "memory");
        }
    }
    __syncthreads();
    const float inv = 1.0f / l;
#pragma unroll
    for (int db = 0; db < NDB; ++db) {
        f32x4 o = (f32x4){0.f, 0.f, 0.f, 0.f};
        const LAS unsigned char* vr = lds + (16 * db + fr) * VROW + g0 * 64 + fq * 16;
#pragma unroll
        for (int pi = 0; pi < NACT; ++pi) o = __builtin_amdgcn_mfma_f32_16x16x32_bf16(*(const LAS bf16x8*)(vr + pi * 64), pf[pi], o, 0, 0, 0);
        const int d = 16 * db + 4 * fq;
        u32x2 z; if (ZPRE) z = zpre[db]; else z = *(const u32x2*)(zp + (long)tq * ldz + d);
        const float y0 = o[0] * inv * bf_lo(z.x), y1 = o[1] * inv * bf_hi(z.x), y2 = o[2] * inv * bf_lo(z.y), y3 = o[3] * inv * bf_hi(z.y);
        *(u32x2*)(op + (long)tq * ldo + d) = (u32x2){cvt_pk_bf16(y0, y1), cvt_pk_bf16(y2, y3)};
    }
}

template <int NG>
__device__ __forceinline__ void gate_item(LAS unsigned char* lds, int tid, int ck, int gbeg, const bf16_t* VBT, const float* PART1, const float* lng, const float* lnb,
                                          const bf16_t* wsb, const float* bsp, const bf16_t* QKZ, bf16_t* OBp) {
    constexpr int VROW = 272, BUF = 128 * VROW;
    const int lane = tid & 63, w = __builtin_amdgcn_readfirstlane(tid >> 6), fr = lane & 15, fq = lane >> 4;
    LAS float* mu = (LAS float*)(lds + 2 * BUF); LAS float* rs = mu + 128;
    const int t = 16 * w + fr; const size_t tok = (size_t)ck * 128 + t;
    __syncthreads();
    if (tid < 128) {
        const f32x4* pp = (const f32x4*)(PART1 + (size_t)(ck * 128 + tid) * 24); float s = 0.f, q = 0.f;
#pragma unroll
        for (int i = 0; i < 6; ++i) { const f32x4 v = pp[i]; s += v[0] + v[2]; q += v[1] + v[3]; }
        const float mean = s * (1.f / 1536.f), var = fmaxf(q * (1.f / 1536.f) - mean * mean, 0.f);
        mu[tid] = mean; rs[tid] = 1.0f / sqrtf(var + EPS);
    }
    u32x4 raw[4];
#pragma unroll
    for (int i = 0; i < 4; ++i) { const int chunk = tid + 512 * i, row = chunk >> 4, cc = chunk & 15; raw[i] = *(const u32x4*)(VBT + (size_t)(gbeg * 128 + row) * M + ck * 128 + cc * 8); }
    __syncthreads();
#pragma unroll 1
    for (int gi = 0; gi < NG; ++gi) {
        const int g = gbeg + gi; LAS unsigned char* buf = lds + (gi & 1) * BUF;
        bf16x8 wf[4];
        { const bf16_t* wp = wsb + ((size_t)g * 128 + t) * 128 + 8 * fq;
#pragma unroll
            for (int k = 0; k < 4; ++k) wf[k] = *(const bf16x8*)(wp + 32 * k); }
        const float bs = bsp[g * 128 + t];
        u32x2 z[8];
#pragma unroll
        for (int cbk = 0; cbk < 8; ++cbk) z[cbk] = *(const u32x2*)(QKZ + tok * QKZ_LD + 3584 + g * 128 + 16 * cbk + 4 * fq);
#pragma unroll
        for (int i = 0; i < 4; ++i) {
            const int chunk = tid + 512 * i, row = chunk >> 4, cc = chunk & 15;
            const float ga = lng[g * 128 + row], be = lnb[g * 128 + row];
            const f32x4 m0 = *(const LAS f32x4*)(mu + cc * 8), m1 = *(const LAS f32x4*)(mu + cc * 8 + 4), r0 = *(const LAS f32x4*)(rs + cc * 8), r1 = *(const LAS f32x4*)(rs + cc * 8 + 4);
            const u32x4 x = raw[i];
            f32x4 a = (f32x4){bf_lo(x.x), bf_hi(x.x), bf_lo(x.y), bf_hi(x.y)}, b = (f32x4){bf_lo(x.z), bf_hi(x.z), bf_lo(x.w), bf_hi(x.w)};
            a = (a - m0) * r0 * ga + be; b = (b - m1) * r1 * ga + be;
            *(LAS u32x4*)(buf + row * VROW + cc * 16) = pack8(a, b);
        }
        if (gi + 1 < NG) {
#pragma unroll
            for (int i = 0; i < 4; ++i) { const int chunk = tid + 512 * i, row = chunk >> 4, cc = chunk & 15; raw[i] = *(const u32x4*)(VBT + (size_t)((g + 1) * 128 + row) * M + ck * 128 + cc * 8); }
        }
        __syncthreads();
#pragma unroll
        for (int cbk = 0; cbk < 8; ++cbk) {
            f32x4 o = (f32x4){0.f, 0.f, 0.f, 0.f};
            const LAS unsigned char* vr = buf + (16 * cbk + fr) * VROW + fq * 16;
#pragma unroll
            for (int k = 0; k < 4; ++k) o = __builtin_amdgcn_mfma_f32_16x16x32_bf16(*(const LAS bf16x8*)(vr + k * 64), wf[k], o, 0, 0, 0);
            const int ch = g * 128 + 16 * cbk + 4 * fq;
            const float y0 = (o[0] + bs) * bf_lo(z[cbk].x), y1 = (o[1] + bs) * bf_hi(z[cbk].x), y2 = (o[2] + bs) * bf_lo(z[cbk].y), y3 = (o[3] + bs) * bf_hi(z[cbk].y);
            *(u32x2*)(OBp + tok * OB_LD + 1536 + ch) = (u32x2){cvt_pk_bf16(y0, y1), cvt_pk_bf16(y2, y3)};
        }
    }
}

#define XB_TMO      128
#define XB_XCNT(j)  (256  + 64 * (j))
#define XB_XSUB(j)  (1280 + 64 * (j))
#define XB_XGEN(j)  (2304 + 64 * (j))
#define XB_TOP      3328
#define XB_TOPGEN   3392
#define XCD_BAR_WORDS 3456
#define XB_SPIN_CAP (1u << 22)
__device__ __forceinline__ unsigned xb_ld(unsigned* p)              { return __hip_atomic_load(p, __ATOMIC_RELAXED, __HIP_MEMORY_SCOPE_AGENT); }
__device__ __forceinline__ unsigned xb_add(unsigned* p, unsigned v) { return __hip_atomic_fetch_add(p, v, __ATOMIC_RELAXED, __HIP_MEMORY_SCOPE_AGENT); }
__device__ __forceinline__ unsigned xb_xcc_id() { return (unsigned)__builtin_amdgcn_s_getreg((3 << 11) | 20) & 0xFu; }
#define XB_SPIN(cond, bar) do { unsigned _sp = 0; while (cond) { __builtin_amdgcn_s_sleep(1); \
    if ((++_sp & 255u) == 0u) { if (xb_ld(&(bar)[XB_TMO])) break; if (_sp > XB_SPIN_CAP) { atomicAdd(&(bar)[XB_TMO], 1u); break; } } } } while (0)
struct XcdBarrier { unsigned* bar; unsigned x; volatile LAS unsigned* st; };
__device__ __forceinline__ XcdBarrier xcd_barrier_post(unsigned* bar, volatile LAS unsigned* st) {
    XcdBarrier b; b.bar = bar; b.x = xb_xcc_id(); b.st = st;
    if (threadIdx.x == 0) (void)xb_add(&bar[XB_XCNT(b.x)], 1u);
    return b;
}
__device__ __forceinline__ void xcd_barrier_complete(unsigned* bar, unsigned x, unsigned& nloc, unsigned& nx) {
    const unsigned G = gridDim.x * gridDim.y * gridDim.z;
    unsigned sum, cnt, mine, sp = 0u;
    for (;;) {
        sum = 0u; cnt = 0u; mine = 0u;
#pragma unroll
        for (unsigned j = 0; j < 16; ++j) { const unsigned c = xb_ld(&bar[XB_XCNT(j)]); sum += c; cnt += (c > 0u) ? 1u : 0u; mine = (j == x) ? c : mine; }
        if (sum == G) break;
        __builtin_amdgcn_s_sleep(1);
        if ((++sp & 255u) == 0u) { if (xb_ld(&bar[XB_TMO])) break; if (sp > XB_SPIN_CAP) { atomicAdd(&bar[XB_TMO], 1u); break; } }
    }
    nloc = mine > 0u ? mine : 1u; nx = cnt > 0u ? cnt : 1u;
}
__device__ __forceinline__ void xcd_barrier(const XcdBarrier& b) {
    asm volatile("s_waitcnt vmcnt(0)" ::: "memory");
    __syncthreads();
    if (threadIdx.x == 0) {
        unsigned* bar = b.bar;
        __builtin_amdgcn_s_waitcnt(0);
        unsigned nloc = b.st[0], nx = b.st[1];
        if (nloc == 0u) { xcd_barrier_complete(bar, b.x, nloc, nx); b.st[0] = nloc; b.st[1] = nx; }
        const unsigned old = xb_add(&bar[XB_XSUB(b.x)], 1u);
        const unsigned gen = old / nloc;
        if (old + 1u == (gen + 1u) * nloc) {
            __builtin_amdgcn_fence(__ATOMIC_RELEASE, "agent");
            asm volatile("s_waitcnt vmcnt(0)" ::: "memory");
            const unsigned og = xb_add(&bar[XB_TOP], 1u);
            const unsigned tg = og / nx;
            if (og + 1u == (tg + 1u) * nx) xb_add(&bar[XB_TOPGEN], 1u);
            else XB_SPIN(xb_ld(&bar[XB_TOPGEN]) == tg, bar);
            __builtin_amdgcn_fence(__ATOMIC_ACQUIRE, "agent");
            xb_add(&bar[XB_XGEN(b.x)], 1u);
            asm volatile("s_waitcnt vmcnt(0)" ::: "memory");
        } else {
            XB_SPIN(xb_ld(&bar[XB_XGEN(b.x)]) == gen, bar);
            __builtin_amdgcn_fence(__ATOMIC_ACQUIRE, "agent");
            asm volatile("s_waitcnt vmcnt(0)" ::: "memory");
        }
    }
    __syncthreads();
}

template <int TMASK>
__global__ void __launch_bounds__(NWAVES * 64, 2) fwd_mega_t(Args args) {
    extern __shared__ __attribute__((aligned(16))) unsigned char lds_raw[];
    LAS unsigned char* lds = (LAS unsigned char*)lds_raw;
    const int tid = threadIdx.x, lane = tid & 63, wave = __builtin_amdgcn_readfirstlane(tid >> 6);
    const int G = gridDim.x, bx = blockIdx.x;
    const int vcu = (G % 8 == 0) ? (bx % 8) * (G / 8) + bx / 8 : bx;
    unsigned char* ws = args.ws;
    const float* x = args.in[0]; const float* mem = args.in[1]; const float* norm_gain = args.in[2]; const float* mem_gain = args.in[3];
    const float* w_in = args.in[4]; const float* sink = args.in[5]; const float* ln_g = args.in[6]; const float* ln_b = args.in[7];
    const float* w_sp = args.in[8]; const float* b_sp = args.in[9]; const float* w_kv = args.in[10]; const float* w_bra = args.in[11];
    const float* w_brb = args.in[12]; const float* w_brc = args.in[13]; const float* w_out = args.in[14]; const float* fin_gain = args.in[15];
    bf16_t* WinT = (bf16_t*)(ws + WS_WINT); bf16_t* H = (bf16_t*)(ws + WS_H); bf16_t* WkvT = (bf16_t*)(ws + WS_WKVT); bf16_t* MemH = (bf16_t*)(ws + WS_MEMH);
    bf16_t* WbrT = (bf16_t*)(ws + WS_WBRT); bf16_t* WoutT = (bf16_t*)(ws + WS_WOUTT); bf16_t* QKZ = (bf16_t*)(ws + WS_QKZ); bf16_t* OBp = (bf16_t*)(ws + WS_OB);
    bf16_t* KMEM = (bf16_t*)(ws + WS_KMEM); bf16_t* VMEMT = (bf16_t*)(ws + WS_VMEMT); float* PART1 = (float*)(ws + WS_PART1); float* PART2 = (float*)(ws + WS_PART2);
    bf16_t* MERGED = (bf16_t*)(ws + WS_MERGED);
    bf16_t* WSPB = (bf16_t*)(ws + 65536);
#if defined(CHK) && CHK == 1
    bf16_t* VAT = (bf16_t*)(ws + WS_OB); bf16_t* VBT = (bf16_t*)(ws + WS_OB + 16 * MiB);
#else
    bf16_t* VAT = (bf16_t*)((unsigned char*)args.out + DO_VAT); bf16_t* VBT = (bf16_t*)((unsigned char*)args.out + DO_VBT);
#endif
    const int lo = args.ph_lo, hi = args.ph_hi;
    const bool defer_w = (G == 256) && (hi - lo > 1);
#ifndef PH_MASK
#define PH_MASK 127
#endif
#define IN(k) ((((PH_MASK) >> (k)) & 1) && ((TMASK >> (k)) & 1) && lo <= (k) && (k) < hi)
    volatile LAS unsigned* MISC = (volatile LAS unsigned*)(lds + LDS_BYTES - 64);
    if (tid < 16) MISC[tid] = 0u;
    __syncthreads();
    XcdBarrier xbar; xbar.bar = (unsigned*)ws; xbar.x = 0; xbar.st = MISC;
    if (hi - lo > 1) xbar = xcd_barrier_post((unsigned*)ws, MISC);
    if (args.chk == 0x7fffffff) cg::this_grid().sync();
#define SEAM(k) do { if (IN(k) && IN((k) + 1)) xcd_barrier(xbar); } while (0)

    if (IN(0)) {
        const int gw = vcu * NWAVES + wave, NGW = G * NWAVES;
        p0_tiles(P0W{w_in, w_kv, w_bra, w_brb, w_brc, w_out, WinT, WkvT, WbrT, WoutT}, defer_w ? 0 : 2, vcu, G, tid, (LAS float*)lds);
        for (int m = 4 * gw; m < M; m += 4 * NGW)
            rms_rows_to_bf16<4>(x + (size_t)m * DM, norm_gain, H + (size_t)m * DM, lane);
        for (int m = gw; m < MM; m += NGW) rms_row_to_bf16(mem + (size_t)m * DM, mem_gain, MemH + (size_t)m * DM, lane);
        { const int gt = gw * 64 + lane;
          if (gt < 12 * 128 * 128 / 8) { const f32x4 a = *(const f32x4*)(w_sp + (size_t)gt * 8), b = *(const f32x4*)(w_sp + (size_t)gt * 8 + 4); *(u32x4*)(WSPB + (size_t)gt * 8) = pack8(a, b); } }
    }
    SEAM(0);
    if (IN(1)) {
        SchedP1 S{bx, G, H, WinT, MemH, WkvT, QKZ, VAT, VBT, KMEM, VMEMT, PART1};
        EpiP1 E;
        pg8::gemm_phase<EpiP1, SchedP1>(lds, S, E);
        if (defer_w && bx >= 160) p0_tiles(P0W{w_in, w_kv, w_bra, w_brb, w_brc, w_out, WinT, WkvT, WbrT, WoutT}, 1, bx - 160, 96, tid, (LAS float*)lds);
    }
    SEAM(1);
    if (IN(2)) {
        for (int it = vcu; it < 2304; it += G) {
            if (it < 512) {
                const int bh = it >> 5, qt = it & 31, b = bh >> 2, hd = bh & 3; const size_t tok0 = (size_t)b * SEQ + qt * 128;
                attn_item<256, 8, 8, false>(lds, tid, QKZ + tok0 * QKZ_LD + 5120 + hd * 256, QKZ_LD, KMEM + (size_t)b * 256 * 1024 + hd * 256, 1024,
                                            VMEMT + (size_t)hd * 256 * 1024 + b * 256, 1024, 0, 256, 0.f, 0.f, LOG2E * 0.0625f,
                                            QKZ + tok0 * QKZ_LD + 6144 + hd * 256, QKZ_LD, OBp + tok0 * OB_LD + 3072 + hd * 256, OB_LD);
            } else if (it < 2048) {
                const int idx = it - 512, r = idx % 3, rest = idx / 3, n = rest & 31, bh = rest >> 5, b = bh >> 2, hkv = bh & 3, hq = hkv * 3 + r;
                const long tok0 = (long)b * SEQ + n * 128;
                const float slope = (hq < 8) ? __builtin_amdgcn_exp2f(-(float)(hq + 1)) : __builtin_amdgcn_exp2f(-((float)(hq - 8) + 0.5f));
                attn_item<128, 12, 9, true>(lds, tid, QKZ + tok0 * QKZ_LD + hq * 128, QKZ_LD, QKZ + (tok0 - 128) * QKZ_LD + 1536 + hkv * 128, QKZ_LD,
                                            VAT + (long)hkv * 128 * M + (tok0 - 128), M, (n == 0) ? 128 : 0, (n == 31) ? 256 : 384,
                                            slope * LOG2E, sink[hq] * LOG2E, LOG2E * 0.08838834764831845f,
                                            QKZ + tok0 * QKZ_LD + 2048 + hq * 128, QKZ_LD, OBp + tok0 * OB_LD + hq * 128, OB_LD);
            } else {
                const int idx = it - 2048, ck = idx >> 1, hf = idx & 1;
                gate_item<6>(lds, tid, ck, hf * 6, VBT, PART1, ln_g, ln_b, WSPB, b_sp, QKZ, OBp);
            }
        }
        __syncthreads();
    }
    SEAM(2);
    if (IN(3)) {
        SchedP3 S{bx, G, H, WinT, OBp, WbrT, MERGED};
        EpiP3 E{(const char*)(ws + WS_SG) + (size_t)bx * 16 * 8192, (const char*)(ws + WS_SM) + (size_t)bx * 32 * 8192};
#ifdef P3_ZFILL
        { GAS u32x4* gz = (GAS u32x4*)(E.sgb + (tid >> 6) * 16384 + (tid & 63) * 16); GAS u32x4* mz = (GAS u32x4*)(E.smb + (tid >> 6) * 32768 + (tid & 63) * 16);
          for (int i = 0; i < 16; ++i) gz[i * 64] = (u32x4){0u, 0u, 0u, 0u};
          for (int i = 0; i < 32; ++i) mz[i * 64] = (u32x4){0u, 0u, 0u, 0u};
          asm volatile("s_waitcnt vmcnt(0)" ::: "memory"); __syncthreads(); }
#endif
        pg8::gemm_phase<EpiP3, SchedP3>(lds, S, E);
    }
    SEAM(3);
    if (IN(4)) {
        SchedP4 S{bx, G, MERGED, WoutT};
        EpiP4 E{(bf16_t*)(ws + WS_QKZ)};
        pg8::gemm_phase<EpiP4, SchedP4>(lds, S, E);
    }
    SEAM(4);
    if (IN(5)) {
        const int gw = vcu * NWAVES + wave, NGW = G * NWAVES;
        const bf16_t* DELTA = (const bf16_t*)(ws + WS_QKZ);
        const f32x4* gr = (const f32x4*)fin_gain + lane;
        for (int m0 = 2 * gw; m0 < M; m0 += 2 * NGW) {
            f32x4 v[2][8]; u32x2 d[2][8];
#pragma unroll
            for (int q = 0; q < 2; ++q) { const f32x4* xr = (const f32x4*)(x + (size_t)(m0 + q) * DM) + lane; const u32x2* dr = (const u32x2*)(DELTA + (size_t)(m0 + q) * DM) + lane;
#pragma unroll
                for (int j = 0; j < 8; ++j) { v[q][j] = __builtin_nontemporal_load(xr + 64 * j); d[q][j] = dr[64 * j]; } }
#pragma unroll
            for (int q = 0; q < 2; ++q) {
                float t = 0.f;
#pragma unroll
                for (int j = 0; j < 8; ++j) { v[q][j] += (f32x4){bf_lo(d[q][j].x), bf_hi(d[q][j].x), bf_lo(d[q][j].y), bf_hi(d[q][j].y)};
                    t += (v[q][j][0] * v[q][j][0] + v[q][j][1] * v[q][j][1]) + (v[q][j][2] * v[q][j][2] + v[q][j][3] * v[q][j][3]); }
                const float rstd = 1.0f / sqrtf(wave_sum(t) * (1.f / DM) + EPS);
                f32x4* o = (f32x4*)(args.out + (size_t)(m0 + q) * DM) + lane;
#pragma unroll
                for (int j = 0; j < 8; ++j) __builtin_nontemporal_store(v[q][j] * rstd * gr[64 * j], o + 64 * j);
            }
        }
    }
#ifdef CHK
    if (IN(6)) {
        const int gw = vcu * NWAVES + wave, NGW = G * NWAVES;
        for (int m = gw; m < M; m += NGW) {
            for (int c = lane; c < DM; c += 64) {
                float v = 0.f;
                if (args.chk == 2) v = bf_lo(OBp[(size_t)m * OB_LD + c]) + bf_lo(OBp[(size_t)m * OB_LD + 2048 + c]);
                else if (args.chk == 3) v = bf_lo(MERGED[(size_t)m * DM + c]);
                else if (args.chk == 1) { v = bf_lo(QKZ[(size_t)m * QKZ_LD + c]) + bf_lo(QKZ[(size_t)m * QKZ_LD + 2048 + c]) + bf_lo(QKZ[(size_t)m * QKZ_LD + 4096 + c]) + (c < 1024 ? bf_lo(QKZ[(size_t)m * QKZ_LD + 6144 + c]) : 0.f)
                        + bf_lo(VAT[(size_t)(c & 511) * M + m]) + bf_lo(VBT[(size_t)(c % 1536) * M + m]) + PART1[(size_t)m * 24 + (c % 24)] + bf_lo(KMEM[(size_t)(m & 1023) * 1024 + (c & 1023)]) + bf_lo(VMEMT[(size_t)(m & 1023) * 1024 + (c & 1023)]); }
                else if (args.chk == 0) v = bf_lo(H[(size_t)m * DM + c]) + bf_lo(WinT[(size_t)m * DM + c]) + bf_lo(WbrT[(size_t)(m & 2047) * OB_LD + c]) + bf_lo(WbrT[(size_t)(m & 2047) * OB_LD + 2048 + c]) + bf_lo(WoutT[(size_t)(m & 2047) * DM + c]) + bf_lo(WkvT[(size_t)(m & 2047) * DM + c]) + bf_lo(MemH[(size_t)(m & 1023) * DM + c]);
                args.out[(size_t)m * DM + c] = v;
            }
        }
    }
#endif
#undef IN
#undef SEAM
}

template <int P> static void launch_one(int grid, hipStream_t stream, const Args& a) {
    static bool init = false;
    if (!init) { (void)hipFuncSetAttribute((const void*)fwd_mega_t<(1 << P)>, hipFuncAttributeMaxDynamicSharedMemorySize, LDS_BYTES); init = true; }
    hipLaunchKernelGGL(fwd_mega_t<(1 << P)>, dim3(grid), dim3(NWAVES * 64), LDS_BYTES, stream, a);
}
static void launch_phase(int p, int grid, hipStream_t stream, const Args& a) {
    switch (p) { case 0: launch_one<0>(grid, stream, a); break; case 1: launch_one<1>(grid, stream, a); break; case 2: launch_one<2>(grid, stream, a); break;
                 case 3: launch_one<3>(grid, stream, a); break; case 4: launch_one<4>(grid, stream, a); break; case 5: launch_one<5>(grid, stream, a); break; default: launch_one<6>(grid, stream, a); break; }
}
extern "C" void kernel_launch(void* const* d_in, const int* in_sizes, int n_in, void* d_out, int out_size, void* d_ws, size_t ws_size, hipStream_t stream) {
    static int grid = 0;
    if (grid == 0) {
        if (n_in != 16 || in_sizes[0] != M * DM || out_size != M * DM || ws_size < WS_END) {
            fprintf(stderr, "kernel_launch: unexpected shapes / workspace (n_in %d, in0 %d, out %d, ws %zu < %zu); nothing launched\n", n_in, n_in > 0 ? in_sizes[0] : -1, out_size, ws_size, (size_t)WS_END);
            grid = -1; return; }
        int dev = 0, cus = 0, per_cu = 0;
        if (hipGetDevice(&dev) != hipSuccess || hipDeviceGetAttribute(&cus, hipDeviceAttributeMultiprocessorCount, dev) != hipSuccess) { grid = -1; return; }
        if (hipFuncSetAttribute((const void*)fwd_mega_t<127>, hipFuncAttributeMaxDynamicSharedMemorySize, LDS_BYTES) != hipSuccess) { fprintf(stderr, "kernel_launch: hipFuncSetAttribute failed\n"); grid = -1; return; }
        if (hipOccupancyMaxActiveBlocksPerMultiprocessor(&per_cu, (const void*)fwd_mega_t<127>, NWAVES * 64, LDS_BYTES) != hipSuccess || per_cu < 1) { fprintf(stderr, "kernel_launch: occupancy query says %d blocks per CU\n", per_cu); (void)hipGetLastError(); grid = -1; return; }
        grid = cus < 256 ? cus : 256;
    }
    if (grid < 0) return;
    Args a{};
    for (int i = 0; i < 16; ++i) a.in[i] = (const float*)d_in[i];
    a.out = (float*)d_out; a.ws = (unsigned char*)d_ws;
#ifdef CHK
    a.chk = CHK;
    for (int p = 0; p <= CHK; ++p) { a.ph_lo = p; a.ph_hi = p + 1; launch_phase(p, grid, stream, a); }
    a.ph_lo = 6; a.ph_hi = 7; launch_phase(6, grid, stream, a);
#elif MK_MULTI
    for (int p = 0; p < 6; ++p) { a.ph_lo = p; a.ph_hi = p + 1; launch_phase(p, grid, stream, a); }
#else
    a.ph_lo = 0; a.ph_hi = 6;
    if (hipMemsetAsync(d_ws, 0, 16384, stream) != hipSuccess) { fprintf(stderr, "kernel_launch: memset of barrier words failed\n"); return; }
    void* kargs[] = {&a};
    hipError_t e = hipLaunchCooperativeKernel((const void*)fwd_mega_t<127>, dim3(grid), dim3(NWAVES * 64), kargs, LDS_BYTES, stream);
    if (e != hipSuccess) fprintf(stderr, "kernel_launch: cooperative launch failed: %s (grid %d)\n", hipGetErrorString(e), grid);
#endif
}
```

```cpp
#include <hip/hip_runtime.h>
#include <hip/hip_cooperative_groups.h>
#include <cstdio>
#include <cstdint>
namespace cg = cooperative_groups;

#ifndef MK_MULTI
#define MK_MULTI 0
#endif

#define LAS __attribute__((address_space(3)))
#define GAS __attribute__((address_space(1)))
typedef unsigned short bf16_t;
typedef short bf16x8 __attribute__((ext_vector_type(8)));
typedef float f32x4 __attribute__((ext_vector_type(4)));
typedef float f32x2 __attribute__((ext_vector_type(2)));
typedef unsigned u32x4 __attribute__((ext_vector_type(4)));
typedef unsigned u32x2 __attribute__((ext_vector_type(2)));

constexpr int DM = 2048, NB = 4, SEQ = 4096, M = NB * SEQ, MEML = 256, MM = NB * MEML;
constexpr int N_IN = 16896;
constexpr int QKZ_LD = 7168;
constexpr int OB_LD = 4096;
constexpr float EPS = 1e-6f;
constexpr float LOG2E = 1.4426950408889634f;

constexpr size_t MiB = 1u << 20;
constexpr size_t WS_WINT = 1 * MiB;
constexpr size_t WS_H = 67 * MiB;
constexpr size_t WS_WKVT = 131 * MiB;
constexpr size_t WS_MEMH = 139 * MiB;
constexpr size_t WS_WBRT = 143 * MiB;
constexpr size_t WS_WOUTT = 159 * MiB;
constexpr size_t WS_QKZ = 167 * MiB;
constexpr size_t WS_SG = WS_QKZ, WS_SM = WS_QKZ + 32 * MiB, WS_MERGED = WS_QKZ + 96 * MiB;
constexpr size_t WS_OB = 391 * MiB;
constexpr size_t WS_KMEM = 519 * MiB;
constexpr size_t WS_VMEMT = 521 * MiB;
constexpr size_t WS_PART1 = 523 * MiB;
constexpr size_t WS_PART2 = 525 * MiB;
constexpr size_t WS_END = 527 * MiB;
constexpr size_t DO_VAT = 0, DO_VBT = 16 * MiB;

constexpr int LDS_BYTES = 147456;
constexpr int NWAVES = 8;

typedef __bf16 bf16x2_t __attribute__((ext_vector_type(2)));
__device__ __forceinline__ unsigned cvt_pk_bf16(float lo, float hi) { const f32x2 v = {lo, hi}; const bf16x2_t b = __builtin_convertvector(v, bf16x2_t); return __builtin_bit_cast(unsigned, b); }
__device__ __forceinline__ float bf_lo(unsigned w) { return __uint_as_float(w << 16); }
__device__ __forceinline__ float bf_hi(unsigned w) { return __uint_as_float(w & 0xffff0000u); }
__device__ __forceinline__ float sigmoidf_(float x) { return __builtin_amdgcn_rcpf(1.0f + __builtin_amdgcn_exp2f(-LOG2E * x)); }
__device__ __forceinline__ float siluf_(float x) { return x * sigmoidf_(x); }
__device__ __forceinline__ f32x4 silu4(f32x4 v) { return (f32x4){siluf_(v[0]), siluf_(v[1]), siluf_(v[2]), siluf_(v[3])}; }
__device__ __forceinline__ f32x4 sigmoid4(f32x4 v) { return (f32x4){sigmoidf_(v[0]), sigmoidf_(v[1]), sigmoidf_(v[2]), sigmoidf_(v[3])}; }
__device__ __forceinline__ f32x2 gelu_pk(f32x2 v) {
    const f32x2 av = __builtin_elementwise_abs(v), d = av * 0.2316418882f + 1.0f;
    f32x2 t; t.x = __builtin_amdgcn_rcpf(d.x); t.y = __builtin_amdgcn_rcpf(d.y);
    f32x2 q = t * 0.5307027145f + (-0.7265760135f); q = q * t + 0.7107068705f; q = q * t + (-0.142248368f); q = q * t + 0.127414796f; q = q * t;
    const f32x2 s = (v * v) * (-0.72134752044f);
    f32x2 e; e.x = __builtin_amdgcn_exp2f(s.x); e.y = __builtin_amdgcn_exp2f(s.y);
    const f32x2 m = v * (q * e), r = v - m;
    f32x2 o; o.x = v.x < 0.f ? m.x : r.x; o.y = v.y < 0.f ? m.y : r.y; return o;
}
__device__ __forceinline__ f32x4 gelu4(f32x4 v) { const f32x2 a = gelu_pk((f32x2){v[0], v[1]}), b = gelu_pk((f32x2){v[2], v[3]}); return (f32x4){a.x, a.y, b.x, b.y}; }
__device__ __forceinline__ u32x4 pack8(f32x4 a, f32x4 b) { u32x4 w; w.x = cvt_pk_bf16(a[0], a[1]); w.y = cvt_pk_bf16(a[2], a[3]); w.z = cvt_pk_bf16(b[0], b[1]); w.w = cvt_pk_bf16(b[2], b[3]); return w; }
__device__ __forceinline__ float wave_sum(float v) {
#pragma unroll
    for (int o = 1; o < 64; o <<= 1) v += __shfl_xor(v, o);
    return v;
}

namespace pg8 {
constexpr int BM = 256, BK = 64, HALF = 128, HTB = HALF * BK * 2, STAGE_BYTES = 8 * HTB;
__host__ __device__ __forceinline__ int lds_byte(int r, int c) { const int st = (r >> 4) * 2 + (c >> 5), rr = r & 15, cc = c & 31, ob = rr * 64 + cc * 2; return st * 1024 + (ob ^ (((ob >> 9) & 1) << 5)); }
__host__ __device__ __forceinline__ void stage_rc(int b, int& R, int& C) { const int st = b / 1024, sb = b % 1024, swz = sb ^ (((sb >> 9) & 1) << 5); R = (st >> 1) * 16 + swz / 64; C = (st & 1) * 32 + (swz % 64) / 2; }
__host__ __device__ __forceinline__ int perm32(int rho) { const int n = rho >> 4, i = rho & 15; return 8 * (i >> 2) + 4 * n + (i & 3); }

struct Unit { const char* A; const char* B; bf16_t* O; float* st; int nt; unsigned pitch; int ldc; int kind; int pm, pn; };

template <class Epi, class Sched>
__device__ __forceinline__ void gemm_phase(LAS unsigned char* lds, const Sched& S, const Epi& E) {
    const int tid = threadIdx.x, wid = __builtin_amdgcn_readfirstlane(tid >> 6), lane = tid & 63, wr = wid >> 2, wc = wid & 3, fr = lane & 15, fq = lane >> 4;
    unsigned rA, rB, cb;
    { int R, C; stage_rc(tid * 16, R, C); rA = (unsigned)R; rB = (unsigned)((R & ~31) + perm32(R & 31)); cb = (unsigned)C * 2u; }
    const unsigned ldsw = (unsigned)wid * 1024u;
    const int aoff = lds_byte(wr * 64 + fr, fq * 8), boff = lds_byte(wc * 32 + fr, fq * 8);
#define PG8_SA(b, h) (((b) * 2 + (h)) * HTB)
#define PG8_SB(b, h) ((4 + (b) * 2 + (h)) * HTB)
#define PG8_STAGE(bufoff, gbase, rr, pit) do { const unsigned o_ = (rr) * (pit) + cb; \
        __builtin_amdgcn_global_load_lds((const unsigned*)((const char*)(gbase) + o_), (LAS unsigned*)(lds + (bufoff) + ldsw), 16, 0, 0); \
        __builtin_amdgcn_global_load_lds((const unsigned*)((const char*)(gbase) + o_ + 64u * (pit)), (LAS unsigned*)(lds + (bufoff) + ldsw + 8192), 16, 0, 0); } while (0)
#define PG8_LDA(dst, b, h) do { _Pragma("unroll") for (int m = 0; m < 4; ++m) _Pragma("unroll") for (int k = 0; k < 2; ++k) dst[m][k] = *(const LAS bf16x8*)(lds + PG8_SA(b, h) + aoff + m * 2048 + k * 1024); } while (0)
#define PG8_LDB(dst, b, h) do { _Pragma("unroll") for (int n = 0; n < 2; ++n) _Pragma("unroll") for (int k = 0; k < 2; ++k) dst[n][k] = *(const LAS bf16x8*)(lds + PG8_SB(b, h) + boff + n * 2048 + k * 1024); } while (0)
#define PG8_MMA(ai, bj, At, Bt) do { __builtin_amdgcn_s_setprio(1); _Pragma("unroll") for (int m = 0; m < 4; ++m) _Pragma("unroll") for (int n = 0; n < 2; ++n) _Pragma("unroll") for (int k = 0; k < 2; ++k) \
        acc[ai][bj][m][n] = __builtin_amdgcn_mfma_f32_16x16x32_bf16(Bt[n][k], At[m][k], acc[ai][bj][m][n], 0, 0, 0); __builtin_amdgcn_s_setprio(0); } while (0)
#define PG8_WAIT_V(n) asm volatile("s_waitcnt vmcnt(" #n ")" ::: "memory")
#define PG8_WAIT_L(n) asm volatile("s_waitcnt lgkmcnt(" #n ")" ::: "memory")
#define PG8_BAR __builtin_amdgcn_s_barrier()
#define PG8_SCHED __builtin_amdgcn_sched_barrier(0)
    Unit cur, nxt; int ui = 0;
    if (!S.next(0, cur)) return;
    f32x4 acc[2][2][4][2];
#pragma unroll
    for (int a = 0; a < 2; ++a)
#pragma unroll
        for (int b = 0; b < 2; ++b)
#pragma unroll
            for (int m = 0; m < 4; ++m)
#pragma unroll
                for (int n = 0; n < 2; ++n) acc[a][b][m][n] = (f32x4){0.f, 0.f, 0.f, 0.f};
    bf16x8 At[4][2], B0[2][2], B1[2][2];
    const char* cA = cur.A; const char* cB = cur.B;
    const size_t kstep = (size_t)(BK * 2);
    {
        const unsigned pc = cur.pitch; const size_t hc = (size_t)HALF * pc;
        PG8_STAGE(PG8_SB(0, 0), cB, rB, pc); PG8_STAGE(PG8_SB(0, 1), cB + hc, rB, pc); PG8_STAGE(PG8_SA(0, 0), cA, rA, pc); PG8_STAGE(PG8_SA(0, 1), cA + hc, rA, pc);
        if (wr == 1) PG8_BAR;
        PG8_WAIT_V(2); PG8_BAR;
        PG8_STAGE(PG8_SB(1, 0), cB + kstep, rB, pc); PG8_STAGE(PG8_SA(1, 0), cA + kstep, rA, pc); PG8_STAGE(PG8_SB(1, 1), cB + hc + kstep, rB, pc);
        PG8_WAIT_V(6); PG8_BAR;
    }
    for (;;) {
        const bool has_next = S.next(ui + 1, nxt);
        const char* nA = has_next ? nxt.A : cA; const char* nB = has_next ? nxt.B : cB;
        const unsigned pc = cur.pitch, pnx = has_next ? nxt.pitch : cur.pitch; const size_t hc = (size_t)HALF * pc;
        const int nt = cur.nt;
        for (int t = 0; t < nt; t += 2) {
            const bool last = (t == nt - 2);
            const char* a1 = cA + (size_t)(t + 1) * kstep;
            const char* a2 = last ? nA : cA + (size_t)(t + 2) * kstep; const char* b2 = last ? nB : cB + (size_t)(t + 2) * kstep;
            const unsigned p2 = last ? pnx : pc; const size_t h2 = (size_t)HALF * p2;
            const char* a3 = a2 + kstep; const char* b3 = b2 + kstep;
            PG8_LDB(B0, 0, 0); PG8_LDB(B1, 0, 1); PG8_SCHED; PG8_LDA(At, 0, 0); PG8_STAGE(PG8_SA(1, 1), a1 + hc, rA, pc);
            PG8_WAIT_V(8); PG8_WAIT_L(0); PG8_BAR; PG8_MMA(0, 0, At, B0); PG8_MMA(0, 1, At, B1); PG8_BAR; PG8_SCHED;
            PG8_LDA(At, 0, 1); PG8_STAGE(PG8_SB(0, 0), b2, rB, p2); PG8_STAGE(PG8_SB(0, 1), b2 + h2, rB, p2); PG8_STAGE(PG8_SA(0, 0), a2, rA, p2);
            PG8_WAIT_V(8); PG8_WAIT_L(0); PG8_BAR; PG8_MMA(1, 0, At, B0); PG8_MMA(1, 1, At, B1); PG8_BAR; PG8_SCHED;
            PG8_LDB(B0, 1, 0); PG8_LDB(B1, 1, 1); PG8_SCHED; PG8_LDA(At, 1, 0); PG8_STAGE(PG8_SA(0, 1), a2 + h2, rA, p2);
            PG8_WAIT_V(8); PG8_WAIT_L(0); PG8_BAR; PG8_MMA(0, 0, At, B0); PG8_MMA(0, 1, At, B1); PG8_BAR; PG8_SCHED;
            PG8_LDA(At, 1, 1); PG8_STAGE(PG8_SB(1, 0), b3, rB, p2); PG8_STAGE(PG8_SB(1, 1), b3 + h2, rB, p2); PG8_STAGE(PG8_SA(1, 0), a3, rA, p2);
            PG8_WAIT_V(8); PG8_WAIT_L(0); PG8_BAR; PG8_MMA(1, 0, At, B0); PG8_MMA(1, 1, At, B1); PG8_BAR; PG8_SCHED;
        }
        if (wr == 0) PG8_BAR;
        E(acc, cur, wr, wc, fr, fq);
        if (!has_next) break;
#pragma unroll
        for (int a = 0; a < 2; ++a)
#pragma unroll
            for (int b = 0; b < 2; ++b)
#pragma unroll
                for (int m = 0; m < 4; ++m)
#pragma unroll
                    for (int n = 0; n < 2; ++n) acc[a][b][m][n] = (f32x4){0.f, 0.f, 0.f, 0.f};
        cur = nxt; cA = nA; cB = nB; ++ui;
        if (wr == 1) PG8_BAR;
    }
    PG8_WAIT_V(0);
    PG8_BAR;
#undef PG8_SA
#undef PG8_SB
#undef PG8_STAGE
#undef PG8_LDA
#undef PG8_LDB
#undef PG8_MMA
#undef PG8_WAIT_V
#undef PG8_WAIT_L
#undef PG8_BAR
#undef PG8_SCHED
}
}
using pg8::Unit;

struct Args { const float* in[16]; float* out; unsigned char* ws; int ph_lo, ph_hi, chk, pad; };

__device__ __forceinline__ void xcd_split(int L, int& xcd, int& w) { xcd = L & 7; w = L >> 3; }

struct SchedP1 {
    int c, G; const bf16_t *H, *WinT, *MemH, *WkvT; bf16_t *QKZ, *VAT, *VBT, *KMEM, *VMEMT; float* PART1;
    __device__ __forceinline__ bool next(int i, Unit& u) const {
        const int L = i * G + c; if (L >= 2720) return false;
        u.nt = 32; u.pitch = 4096u; u.st = nullptr;
        if (L < 2688) {
            int xcd, w; xcd_split(L, xcd, w);
            const int pm = 8 * xcd + (w & 7), jn = w >> 3;
            const char* hrow = (const char*)(H + (size_t)pm * 256 * DM); const char* wrow = (const char*)(WinT + (size_t)jn * 256 * DM);
            u.pm = pm; u.pn = jn;
            const bool sw = (jn == 8 || jn == 9 || (jn >= 28 && jn < 34));
            if (!sw) {
                u.A = hrow; u.B = wrow; u.ldc = QKZ_LD;
                int col, kind;
                if (jn < 8) { col = jn * 256; kind = 0; }
                else if (jn < 16) { col = 2048 + (jn - 10) * 256; kind = 1; }
                else if (jn < 28) { col = 3584 + (jn - 16) * 128; kind = 2; }
                else if (jn < 38) { col = 5120 + (jn - 34) * 256; kind = 0; }
                else { col = 6144 + (jn - 38) * 256; kind = 1; }
                u.kind = kind; u.O = QKZ + (size_t)pm * 256 * QKZ_LD + col;
            } else {
                u.A = wrow; u.B = hrow; u.ldc = M;
                if (jn < 10) { u.kind = 3; u.O = VAT + (size_t)(jn - 8) * 256 * M + pm * 256; }
                else { u.kind = 4; u.O = VBT + (size_t)(jn - 28) * 256 * M + pm * 256; u.st = PART1 + (size_t)pm * 256 * 24 + (jn - 28) * 4; }
            }
        } else {
            const int e = L - 2688; u.pm = 0; u.pn = 0;
            if (e < 16) { const int pm = e & 3, pn = e >> 2; u.A = (const char*)(MemH + (size_t)pm * 256 * DM); u.B = (const char*)(WkvT + (size_t)pn * 256 * DM);
                u.kind = 0; u.ldc = 1024; u.O = KMEM + (size_t)pm * 256 * 1024 + pn * 256; }
            else { const int e2 = e - 16, pa = e2 >> 2, pb = e2 & 3; u.A = (const char*)(WkvT + (size_t)(1024 + pa * 256) * DM); u.B = (const char*)(MemH + (size_t)pb * 256 * DM);
                u.kind = 3; u.ldc = 1024; u.O = VMEMT + (size_t)pa * 256 * 1024 + pb * 256; }
        }
        return true;
    }
};
struct EpiP1 {
    __device__ __forceinline__ void operator()(const f32x4 (&acc)[2][2][4][2], const Unit& u, int wr, int wc, int fr, int fq) const {
        bf16_t* base = u.O + (size_t)(wr * 64 + fr) * u.ldc + wc * 32 + 8 * fq;
        const int kind = u.kind; const size_t ldc = (size_t)u.ldc;
        if (kind == 2) {
#pragma unroll
            for (int ai = 0; ai < 2; ++ai)
#pragma unroll
                for (int m = 0; m < 4; ++m) {
                    const f32x4 g0 = gelu4(acc[ai][0][m][0]), g1 = gelu4(acc[ai][0][m][1]), s0 = silu4(acc[ai][1][m][0]), s1 = silu4(acc[ai][1][m][1]);
                    *(u32x4*)(base + (size_t)(ai * 128 + m * 16) * ldc) = pack8(g0 * s0, g1 * s1);
                    asm volatile("" ::: "memory");
                }
        } else if (kind == 4) {
#pragma unroll
            for (int bj = 0; bj < 2; ++bj) {
                f32x4 s0 = (f32x4){0.f, 0.f, 0.f, 0.f}, s1 = s0, q0 = s0, q1 = s0;
#pragma unroll
                for (int ai = 0; ai < 2; ++ai)
#pragma unroll
                    for (int m = 0; m < 4; ++m) {
                        const f32x4 v0 = gelu4(acc[ai][bj][m][0]), v1 = gelu4(acc[ai][bj][m][1]);
                        s0 += v0; s1 += v1; q0 += v0 * v0; q1 += v1 * v1;
                        *(u32x4*)(base + (size_t)(ai * 128 + m * 16) * ldc + bj * 128) = pack8(v0, v1);
                        asm volatile("" ::: "memory");
                    }
#pragma unroll
                for (int n = 0; n < 2; ++n)
#pragma unroll
                    for (int j = 0; j < 4; ++j) {
                        float a = n ? s1[j] : s0[j], b = n ? q1[j] : q0[j];
#pragma unroll
                        for (int o = 1; o < 16; o <<= 1) { a += __shfl_xor(a, o); b += __shfl_xor(b, o); }
                        if (fr == 0) *(f32x2*)(u.st + (size_t)(bj * 128 + wc * 32 + 8 * fq + 4 * n + j) * 24 + wr * 2) = (f32x2){a, b};
                    }
                asm volatile("" ::: "memory");
            }
        } else {
            const bool act = (kind == 1);
#pragma unroll
            for (int ai = 0; ai < 2; ++ai)
#pragma unroll
                for (int m = 0; m < 4; ++m)
#pragma unroll
                    for (int bj = 0; bj < 2; ++bj) {
                        f32x4 v0 = acc[ai][bj][m][0], v1 = acc[ai][bj][m][1];
                        if (act) { v0 = silu4(v0); v1 = silu4(v1); }
                        *(u32x4*)(base + (size_t)(ai * 128 + m * 16) * ldc + bj * 128) = pack8(v0, v1);
                    }
        }
    }
};

struct SchedP3 {
    int c, G; const bf16_t *H, *WinT, *OBp, *WbrT; bf16_t* MERGED;
    __device__ __forceinline__ bool next(int i, Unit& u) const {
        const int T = (i / 6) * G + c, sub = i % 6; if (T >= 512) return false;
        int xcd, w; xcd_split(T, xcd, w);
        const int pm = 8 * xcd + (w & 7), pn = w >> 3, br = sub >> 1;
        u.pm = pm; u.pn = pn; u.st = nullptr; u.ldc = DM; u.O = MERGED + (size_t)pm * 256 * DM + pn * 256;
        if ((sub & 1) == 0) { u.kind = 0; u.nt = 32; u.pitch = 4096u; u.A = (const char*)(H + (size_t)pm * 256 * DM); u.B = (const char*)(WinT + (size_t)(10752 + br * 2048 + pn * 256) * DM); }
        else { const int koff = br * 1536; u.kind = 1 + br; u.nt = (br == 2) ? 16 : 24; u.pitch = 8192u;
            u.A = (const char*)(OBp + (size_t)pm * 256 * OB_LD + koff); u.B = (const char*)(WbrT + (size_t)pn * 256 * OB_LD + koff); }
        return true;
    }
};
struct EpiP3 {
    const char* sgb; const char* smb;
    template <int KIND>
    __device__ __forceinline__ void run(const f32x4 (&acc)[2][2][4][2], const Unit& u, int wr, int wc, int fr, int fq) const {
        char* gw_ = const_cast<char*>(sgb) + (threadIdx.x >> 6) * 16384 + (threadIdx.x & 63) * 16;
        char* mw_ = const_cast<char*>(smb) + (threadIdx.x >> 6) * 16384 + (threadIdx.x & 63) * 16;
        asm volatile("" : "+v"(gw_), "+v"(mw_));
#pragma unroll
        for (int ai = 0; ai < 2; ++ai)
#pragma unroll
            for (int bj = 0; bj < 2; ++bj)
#pragma unroll
                for (int m = 0; m < 4; ++m) {
                    const int idx = (ai * 2 + bj) * 4 + m;
                    GAS u32x4* gp = (GAS u32x4*)(gw_ + idx * 1024);
                    GAS u32x4* mp = (GAS u32x4*)(mw_ + idx * 1024);
                    if (KIND == 0) { *gp = pack8(sigmoid4(acc[ai][bj][m][0]), sigmoid4(acc[ai][bj][m][1])); }
                    else {
                        const u32x4 w = *gp;
                        f32x4 v0 = acc[ai][bj][m][0] * (f32x4){bf_lo(w.x), bf_hi(w.x), bf_lo(w.y), bf_hi(w.y)};
                        f32x4 v1 = acc[ai][bj][m][1] * (f32x4){bf_lo(w.z), bf_hi(w.z), bf_lo(w.w), bf_hi(w.w)};
                        if (KIND >= 2) { const u32x4 pm_ = *mp; v0 += (f32x4){bf_lo(pm_.x), bf_hi(pm_.x), bf_lo(pm_.y), bf_hi(pm_.y)}; v1 += (f32x4){bf_lo(pm_.z), bf_hi(pm_.z), bf_lo(pm_.w), bf_hi(pm_.w)}; }
                        if (KIND <= 2) { *mp = pack8(v0, v1); }
                        else { bf16_t* base = u.O + (size_t)(wr * 64 + fr) * DM + wc * 32 + 8 * fq; *(u32x4*)(base + (size_t)(ai * 128 + m * 16) * DM + bj * 128) = pack8(v0, v1); }
                    }
                    asm volatile("" ::: "memory");
                }
    }
    __device__ __forceinline__ void operator()(const f32x4 (&acc)[2][2][4][2], const Unit& u, int wr, int wc, int fr, int fq) const {
        const int kind = u.kind;
        if (kind == 0) run<0>(acc, u, wr, wc, fr, fq); else if (kind == 1) run<1>(acc, u, wr, wc, fr, fq); else if (kind == 2) run<2>(acc, u, wr, wc, fr, fq); else run<3>(acc, u, wr, wc, fr, fq);
    }
};

struct SchedP4 {
    int c, G; const bf16_t *MERGED, *WoutT;
    __device__ __forceinline__ bool next(int i, Unit& u) const {
        const int T = i * G + c; if (T >= 512) return false;
        int xcd, w; xcd_split(T, xcd, w);
        const int pm = 8 * xcd + (w & 7), pn = w >> 3;
        u.pm = pm; u.pn = pn; u.st = nullptr; u.ldc = DM; u.O = nullptr; u.kind = 0; u.nt = 32; u.pitch = 4096u;
        u.A = (const char*)(MERGED + (size_t)pm * 256 * DM); u.B = (const char*)(WoutT + (size_t)pn * 256 * DM);
        return true;
    }
};
struct EpiP4 {
    bf16_t* delta;
    __device__ __forceinline__ void operator()(const f32x4 (&acc)[2][2][4][2], const Unit& u, int wr, int wc, int fr, int fq) const {
        bf16_t* base = delta + (size_t)(u.pm * 256 + wr * 64 + fr) * DM + u.pn * 256 + wc * 32 + 8 * fq;
#pragma unroll
        for (int ai = 0; ai < 2; ++ai)
#pragma unroll
            for (int m = 0; m < 4; ++m)
#pragma unroll
                for (int bj = 0; bj < 2; ++bj) *(u32x4*)(base + (size_t)(ai * 128 + m * 16) * DM + bj * 128) = pack8(acc[ai][bj][m][0], acc[ai][bj][m][1]);
    }
};

__device__ __forceinline__ int map_in(int n) {
    if (n < 4096 || n >= 8704) return n;
    if (n < 5632) { const int j = (n - 4096) >> 7, r = (n - 4096) & 127; return 4096 + 256 * j + r; }
    if (n < 7168) return 7168 + (n - 5632);
    { const int j = (n - 7168) >> 7, r = (n - 7168) & 127; return 4096 + 256 * j + 128 + r; }
}
__device__ __forceinline__ void p0_transpose_item(const float* W, int N, bf16_t* WT, int ldt, int koff, bool remap, LAS float* scr, int item, int lane) {
    const int nblk = N / 32, kb = item / nblk, nb = item % nblk, k0 = 64 * kb, n0 = 32 * nb;
#pragma unroll 8
    for (int i = 0; i < 32; ++i) { const int kk = 2 * i + (lane >> 5); scr[kk * 33 + (lane & 31)] = W[(size_t)(k0 + kk) * N + n0 + (lane & 31)]; }
    asm volatile("s_waitcnt lgkmcnt(0)" ::: "memory");
    const int c = lane & 7; const int d0 = remap ? map_in(n0) : n0;
#pragma unroll
    for (int j = 0; j < 4; ++j) { const int n = (lane >> 3) + 8 * j; const LAS float* s = scr + (8 * c) * 33 + n;
        u32x4 o; o.x = cvt_pk_bf16(s[0 * 33], s[1 * 33]); o.y = cvt_pk_bf16(s[2 * 33], s[3 * 33]); o.z = cvt_pk_bf16(s[4 * 33], s[5 * 33]); o.w = cvt_pk_bf16(s[6 * 33], s[7 * 33]);
        *(u32x4*)(WT + (size_t)(d0 + n) * ldt + koff + k0 + 8 * c) = o; }
    asm volatile("s_waitcnt lgkmcnt(0)" ::: "memory");
}
struct P0Job { const float* W; bf16_t* WT; int N, ldt, koff, k0, n0, d0; };
__device__ __forceinline__ void p0t_load(const P0Job& j, int tid, f32x4 (&v)[8]) {
#pragma unroll
    for (int i = 0; i < 8; ++i) { const int chunk = tid + 512 * i, k = chunk >> 5, cc = chunk & 31; v[i] = __builtin_nontemporal_load((const f32x4*)(j.W + (size_t)(j.k0 + k) * j.N + j.n0 + cc * 4)); }
}
__device__ __forceinline__ void p0t_store(const P0Job& j, int tid, const f32x4 (&v)[8], LAS float* scr) {
    __syncthreads();
#pragma unroll
    for (int i = 0; i < 8; ++i) { const int chunk = tid + 512 * i, k = chunk >> 5, cc = chunk & 31; LAS float* d = scr + k * 129 + cc * 4; d[0] = v[i][0]; d[1] = v[i][1]; d[2] = v[i][2]; d[3] = v[i][3]; }
    __syncthreads();
#pragma unroll
    for (int i = 0; i < 4; ++i) {
        const int chunk = tid + 512 * i, n = (chunk & 15) + 16 * (chunk >> 8), c = (chunk >> 4) & 15;
        const LAS float* sp = scr + (8 * c) * 129 + n;
        u32x4 o; o.x = cvt_pk_bf16(sp[0 * 129], sp[1 * 129]); o.y = cvt_pk_bf16(sp[2 * 129], sp[3 * 129]); o.z = cvt_pk_bf16(sp[4 * 129], sp[5 * 129]); o.w = cvt_pk_bf16(sp[6 * 129], sp[7 * 129]);
        *(u32x4*)(j.WT + (size_t)(j.d0 + n) * j.ldt + j.koff + j.k0 + 8 * c) = o;
    }
}
__device__ __forceinline__ void rms_2rows_to_bf16(const float* xrow0, const float* xrow1, const float* gain, bf16_t* orow0, bf16_t* orow1, int lane) {
    const f32x4* x0 = (const f32x4*)xrow0 + lane; const f32x4* x1 = (const f32x4*)xrow1 + lane; const f32x4* gr = (const f32x4*)gain + lane;
    f32x4 v0[8], v1[8]; float s0 = 0.f, s1 = 0.f;
#pragma unroll
    for (int j = 0; j < 8; ++j) { v0[j] = __builtin_nontemporal_load(x0 + 64 * j); v1[j] = __builtin_nontemporal_load(x1 + 64 * j); }
#pragma unroll
    for (int j = 0; j < 8; ++j) { s0 += (v0[j][0] * v0[j][0] + v0[j][1] * v0[j][1]) + (v0[j][2] * v0[j][2] + v0[j][3] * v0[j][3]); s1 += (v1[j][0] * v1[j][0] + v1[j][1] * v1[j][1]) + (v1[j][2] * v1[j][2] + v1[j][3] * v1[j][3]); }
    const float r0 = 1.0f / sqrtf(wave_sum(s0) * (1.f / DM) + EPS), r1 = 1.0f / sqrtf(wave_sum(s1) * (1.f / DM) + EPS);
    u32x2* o0 = (u32x2*)orow0 + lane; u32x2* o1 = (u32x2*)orow1 + lane;
#pragma unroll
    for (int j = 0; j < 8; ++j) { const f32x4 g = gr[64 * j]; const f32x4 y0 = v0[j] * r0 * g, y1 = v1[j] * r1 * g;
        o0[64 * j] = (u32x2){cvt_pk_bf16(y0[0], y0[1]), cvt_pk_bf16(y0[2], y0[3])}; o1[64 * j] = (u32x2){cvt_pk_bf16(y1[0], y1[1]), cvt_pk_bf16(y1[2], y1[3])}; }
}
template <int NR>
__device__ __forceinline__ void rms_rows_to_bf16(const float* xrow, const float* gain, bf16_t* orow, int lane) {
    const f32x4* gr = (const f32x4*)gain + lane;
    f32x4 v[NR][8]; float s[NR];
#pragma unroll
    for (int q = 0; q < NR; ++q) { const f32x4* xq = (const f32x4*)(xrow + (size_t)q * DM) + lane;
#pragma unroll
        for (int j = 0; j < 8; ++j) v[q][j] = __builtin_nontemporal_load(xq + 64 * j); }
#pragma unroll
    for (int q = 0; q < NR; ++q) { float t = 0.f;
#pragma unroll
        for (int j = 0; j < 8; ++j) t += (v[q][j][0] * v[q][j][0] + v[q][j][1] * v[q][j][1]) + (v[q][j][2] * v[q][j][2] + v[q][j][3] * v[q][j][3]);
        s[q] = 1.0f / sqrtf(wave_sum(t) * (1.f / DM) + EPS); }
#pragma unroll
    for (int q = 0; q < NR; ++q) { u32x2* o = (u32x2*)(orow + (size_t)q * DM) + lane;
#pragma unroll
        for (int j = 0; j < 8; ++j) { const f32x4 y = v[q][j] * s[q] * gr[64 * j]; o[64 * j] = (u32x2){cvt_pk_bf16(y[0], y[1]), cvt_pk_bf16(y[2], y[3])}; } }
}
__device__ __forceinline__ void rms_row_to_bf16(const float* xrow, const float* gain, bf16_t* orow, int lane) {
    const f32x4* xr = (const f32x4*)xrow + lane; const f32x4* gr = (const f32x4*)gain + lane;
    f32x4 v[8]; float s = 0.f;
#pragma unroll
    for (int j = 0; j < 8; ++j) { v[j] = xr[64 * j]; s += (v[j][0] * v[j][0] + v[j][1] * v[j][1]) + (v[j][2] * v[j][2] + v[j][3] * v[j][3]); }
    const float rstd = 1.0f / sqrtf(wave_sum(s) * (1.f / DM) + EPS);
    u32x2* o8 = (u32x2*)orow + lane;
#pragma unroll
    for (int j = 0; j < 8; ++j) { const f32x4 g = gr[64 * j]; const f32x4 y = v[j] * rstd * g; o8[64 * j] = (u32x2){cvt_pk_bf16(y[0], y[1]), cvt_pk_bf16(y[2], y[3])}; }
}


struct P0W { const float *w_in, *w_kv, *w_bra, *w_brb, *w_brc, *w_out; bf16_t *WinT, *WkvT, *WbrT, *WoutT; };
__device__ __forceinline__ void p0_mk(const P0W& p, int set, int it, P0Job& j) {
    constexpr int KB = DM / 128, NIN = N_IN / 128, NG0 = 84, T_KV = KB * (DM / 128), T_A = (1536 / 128) * (DM / 128), T_C = (1024 / 128) * (DM / 128);
    int r = it; const float* W; bf16_t* WT; int N = DM, ldt = DM, koff = 0, kb, nb; bool remap = false;
    const int n_in = (set == 0) ? KB * NG0 : (set == 1) ? KB * (NIN - NG0) : KB * NIN, ncol = (set == 0) ? NG0 : (set == 1) ? (NIN - NG0) : NIN, col0 = (set == 1) ? NG0 : 0;
    bool found = false;
    if (r < n_in) { W = p.w_in; WT = p.WinT; N = N_IN; remap = true; kb = r / ncol; nb = col0 + r % ncol; found = true; }
    else r -= n_in;
    if (!found && set != 1) { if (r < T_KV) { W = p.w_kv; WT = p.WkvT; kb = r / 16; nb = r % 16; found = true; } else r -= T_KV; }
    if (!found) {
        if (r < T_A) { W = p.w_bra; WT = p.WbrT; ldt = OB_LD; koff = 0; }
        else if ((r -= T_A) < T_A) { W = p.w_brb; WT = p.WbrT; ldt = OB_LD; koff = 1536; }
        else if ((r -= T_A) < T_C) { W = p.w_brc; WT = p.WbrT; ldt = OB_LD; koff = 3072; }
        else { r -= T_C; W = p.w_out; WT = p.WoutT; }
        kb = r / 16; nb = r % 16;
    }
    j.W = W; j.WT = WT; j.N = N; j.ldt = ldt; j.koff = koff; j.k0 = 128 * kb; j.n0 = 128 * nb; j.d0 = remap ? map_in(128 * nb) : 128 * nb;
}
__host__ __device__ constexpr int p0_count(int set) {
    constexpr int KB = DM / 128, NIN = N_IN / 128, NG0 = 84, T_KV = KB * (DM / 128), REST = 2 * (1536 / 128) * (DM / 128) + (1024 / 128) * (DM / 128) + T_KV;
    return set == 0 ? KB * NG0 + T_KV : set == 1 ? KB * (NIN - NG0) + REST : KB * NIN + T_KV + REST;
}
__device__ __forceinline__ void p0_tiles(const P0W& p, int set, int first, int stride, int tid, LAS float* scr) {
    const int NT = p0_count(set);
    f32x4 va[8], vb[8]; P0Job ja, jb;
    int it = first;
    if (it < NT) { p0_mk(p, set, it, ja); p0t_load(ja, tid, va); }
    while (it < NT) {
        const int it2 = it + stride; const bool h2 = it2 < NT;
        if (h2) { p0_mk(p, set, it2, jb); p0t_load(jb, tid, vb); }
        p0t_store(ja, tid, va, scr);
        it = it2; if (!h2) break;
        const int it3 = it + stride; const bool h3 = it3 < NT;
        if (h3) { p0_mk(p, set, it3, ja); p0t_load(ja, tid, va); }
        p0t_store(jb, tid, vb, scr);
        it = it3;
    }
    __syncthreads();
}

template <int DH, int NPAIR, int NACT, bool WIN>
__device__ __forceinline__ void attn_item(LAS unsigned char* lds, int tid, const bf16_t* qp, int ldq, const bf16_t* kp, int ldk, const bf16_t* vtp, int ldv,
                                          int lo, int hi, float slope2, float sink2, float qk2, const bf16_t* zp, int ldz, bf16_t* op, int ldo) {
    constexpr int NK = 32 * NPAIR, KROW = DH * 2 + 16, CPR = DH / 8, VROW = NK * 2 + 16, CPRV = NK / 8, NS = DH / 32, NDB = DH / 16;
    const int lane = tid & 63, w = __builtin_amdgcn_readfirstlane(tid >> 6), fr = lane & 15, fq = lane >> 4;
    const int g0 = WIN ? (w >> 1) : 0;
    __syncthreads();
    {
        constexpr int PER = NK * CPR / 512;
        constexpr int BT = (PER % 8 == 0) ? 8 : 6;
#pragma unroll 1
        for (int i0 = 0; i0 < PER; i0 += BT) {
            u32x4 v[BT];
#pragma unroll
            for (int i = 0; i < BT; ++i) {
                const int chunk = tid + 512 * (i0 + i), row = chunk / CPR, cc = chunk % CPR;
                int src = row; if (row < lo) src += 128; if (row >= hi) src -= 128;
                v[i] = *(const u32x4*)(kp + (long)src * ldk + cc * 8);
            }
#pragma unroll
            for (int i = 0; i < BT; ++i) {
                const int chunk = tid + 512 * (i0 + i), row = chunk / CPR, cc = chunk % CPR;
                const int k5 = row & 31, slot = (row & ~31) + 16 * ((k5 >> 2) & 1) + 4 * (k5 >> 3) + (k5 & 3);
                *(LAS u32x4*)(lds + slot * KROW + cc * 16) = v[i];
            }
            asm volatile("" ::: "memory");
        }
    }
    bf16x8 qf[NS];
#pragma unroll
    for (int s = 0; s < NS; ++s) qf[s] = *(const bf16x8*)(qp + (long)(16 * w + fr) * ldq + 32 * s + 8 * fq);
    constexpr bool ZPRE = WIN;
    u32x2 zpre[ZPRE ? NDB : 1];
    if (ZPRE) {
#pragma unroll
        for (int db = 0; db < NDB; ++db) zpre[db] = *(const u32x2*)(zp + (long)(16 * w + fr) * ldz + 16 * db + 4 * fq);
    }
    __syncthreads();
    f32x4 sc[NACT][2];
#pragma unroll
    for (int pi = 0; pi < NACT; ++pi)
#pragma unroll
        for (int blk = 0; blk < 2; ++blk) {
            f32x4 a = (f32x4){0.f, 0.f, 0.f, 0.f};
            const LAS unsigned char* kr = lds + (32 * (g0 + pi) + 16 * blk + fr) * KROW + fq * 16;
#pragma unroll
            for (int s = 0; s < NS; ++s) a = __builtin_amdgcn_mfma_f32_16x16x32_bf16(*(const LAS bf16x8*)(kr + s * 64), qf[s], a, 0, 0, 0);
            sc[pi][blk] = a;
        }
    const int tq = 16 * w + fr;
    float mx = -1e30f;
#pragma unroll
    for (int pi = 0; pi < NACT; ++pi)
#pragma unroll
        for (int blk = 0; blk < 2; ++blk)
#pragma unroll
            for (int r = 0; r < 4; ++r) {
                float v = sc[pi][blk][r] * qk2;
                if (WIN) { const int kk = 32 * (g0 + pi) + 8 * fq + 4 * blk + r; const int dist = abs(tq - (kk - 128));
                    v = v - slope2 * (float)dist; if (dist > 128 || kk < lo || kk >= hi) v = -1e30f; }
                sc[pi][blk][r] = v; mx = fmaxf(mx, v);
            }
    mx = fmaxf(mx, __shfl_xor(mx, 16)); mx = fmaxf(mx, __shfl_xor(mx, 32));
    if (WIN) mx = fmaxf(mx, sink2);
    float l = 0.f; bf16x8 pf[NACT];
#pragma unroll
    for (int pi = 0; pi < NACT; ++pi) {
        f32x4 p0, p1;
#pragma unroll
        for (int r = 0; r < 4; ++r) { p0[r] = __builtin_amdgcn_exp2f(sc[pi][0][r] - mx); p1[r] = __builtin_amdgcn_exp2f(sc[pi][1][r] - mx); }
        l += (p0[0] + p0[1]) + (p0[2] + p0[3]) + (p1[0] + p1[1]) + (p1[2] + p1[3]);
        const u32x4 pk = pack8(p0, p1); pf[pi] = __builtin_bit_cast(bf16x8, pk);
    }
    l += __shfl_xor(l, 16); l += __shfl_xor(l, 32);
    if (WIN) l += __builtin_amdgcn_exp2f(sink2 - mx);
    __syncthreads();
    {
        constexpr int PER = DH * CPRV / 512;
        constexpr int BT = (PER % 8 == 0) ? 8 : 6;
#pragma unroll 1
        for (int i0 = 0; i0 < PER; i0 += BT) {
            u32x4 v[BT];
#pragma unroll
            for (int i = 0; i < BT; ++i) {
                const int chunk = tid + 512 * (i0 + i), row = chunk / CPRV, cc = chunk % CPRV;
                int kk = cc * 8; if (kk < lo) kk += 128; if (kk >= hi) kk -= 128;
                v[i] = *(const u32x4*)(vtp + (long)row * ldv + kk);
            }
#pragma unroll
            for (int i = 0; i < BT; ++i) { const int chunk = tid + 512 * (i0 + i), row = chunk / CPRV, cc = chunk % CPRV; *(LAS u32x4*)(lds + row * VROW + cc * 16) = v[i]; }
            asm volatile("" ::: "memory");
        }
    }
    __syncthreads();
    const float inv = 1.0f / l;
#pragma unroll
    for (int db = 0; db < NDB; ++db) {
        f32x4 o = (f32x4){0.f, 0.f, 0.f, 0.f};
        const LAS unsigned char* vr = lds + (16 * db + fr) * VROW + g0 * 64 + fq * 16;
#pragma unroll
        for (int pi = 0; pi < NACT; ++pi) o = __builtin_amdgcn_mfma_f32_16x16x32_bf16(*(const LAS bf16x8*)(vr + pi * 64), pf[pi], o, 0, 0, 0);
        const int d = 16 * db + 4 * fq;
        u32x2 z; if (ZPRE) z = zpre[db]; else z = *(const u32x2*)(zp + (long)tq * ldz + d);
        const float y0 = o[0] * inv * bf_lo(z.x), y1 = o[1] * inv * bf_hi(z.x), y2 = o[2] * inv * bf_lo(z.y), y3 = o[3] * inv * bf_hi(z.y);
        *(u32x2*)(op + (long)tq * ldo + d) = (u32x2){cvt_pk_bf16(y0, y1), cvt_pk_bf16(y2, y3)};
    }
}

template <int NG>
__device__ __forceinline__ void gate_item(LAS unsigned char* lds, int tid, int ck, int gbeg, const bf16_t* VBT, const float* PART1, const float* lng, const float* lnb,
                                          const bf16_t* wsb, const float* bsp, const bf16_t* QKZ, bf16_t* OBp) {
    constexpr int VROW = 272, BUF = 128 * VROW;
    const int lane = tid & 63, w = __builtin_amdgcn_readfirstlane(tid >> 6), fr = lane & 15, fq = lane >> 4;
    LAS float* mu = (LAS float*)(lds + 2 * BUF); LAS float* rs = mu + 128;
    const int t = 16 * w + fr; const size_t tok = (size_t)ck * 128 + t;
    __syncthreads();
    if (tid < 128) {
        const f32x4* pp = (const f32x4*)(PART1 + (size_t)(ck * 128 + tid) * 24); float s = 0.f, q = 0.f;
#pragma unroll
        for (int i = 0; i < 6; ++i) { const f32x4 v = pp[i]; s += v[0] + v[2]; q += v[1] + v[3]; }
        const float mean = s * (1.f / 1536.f), var = fmaxf(q * (1.f / 1536.f) - mean * mean, 0.f);
        mu[tid] = mean; rs[tid] = 1.0f / sqrtf(var + EPS);
    }
    u32x4 raw[4];
#pragma unroll
    for (int i = 0; i < 4; ++i) { const int chunk = tid + 512 * i, row = chunk >> 4, cc = chunk & 15; raw[i] = *(const u32x4*)(VBT + (size_t)(gbeg * 128 + row) * M + ck * 128 + cc * 8); }
    __syncthreads();
#pragma unroll 1
    for (int gi = 0; gi < NG; ++gi) {
        const int g = gbeg + gi; LAS unsigned char* buf = lds + (gi & 1) * BUF;
        bf16x8 wf[4];
        { const bf16_t* wp = wsb + ((size_t)g * 128 + t) * 128 + 8 * fq;
#pragma unroll
            for (int k = 0; k < 4; ++k) wf[k] = *(const bf16x8*)(wp + 32 * k); }
        const float bs = bsp[g * 128 + t];
        u32x2 z[8];
#pragma unroll
        for (int cbk = 0; cbk < 8; ++cbk) z[cbk] = *(const u32x2*)(QKZ + tok * QKZ_LD + 3584 + g * 128 + 16 * cbk + 4 * fq);
#pragma unroll
        for (int i = 0; i < 4; ++i) {
            const int chunk = tid + 512 * i, row = chunk >> 4, cc = chunk & 15;
            const float ga = lng[g * 128 + row], be = lnb[g * 128 + row];
            const f32x4 m0 = *(const LAS f32x4*)(mu + cc * 8), m1 = *(const LAS f32x4*)(mu + cc * 8 + 4), r0 = *(const LAS f32x4*)(rs + cc * 8), r1 = *(const LAS f32x4*)(rs + cc * 8 + 4);
            const u32x4 x = raw[i];
            f32x4 a = (f32x4){bf_lo(x.x), bf_hi(x.x), bf_lo(x.y), bf_hi(x.y)}, b = (f32x4){bf_lo(x.z), bf_hi(x.z), bf_lo(x.w), bf_hi(x.w)};
            a = (a - m0) * r0 * ga + be; b = (b - m1) * r1 * ga + be;
            *(LAS u32x4*)(buf + row * VROW + cc * 16) = pack8(a, b);
        }
        if (gi + 1 < NG) {
#pragma unroll
            for (int i = 0; i < 4; ++i) { const int chunk = tid + 512 * i, row = chunk >> 4, cc = chunk & 15; raw[i] = *(const u32x4*)(VBT + (size_t)((g + 1) * 128 + row) * M + ck * 128 + cc * 8); }
        }
        __syncthreads();
#pragma unroll
        for (int cbk = 0; cbk < 8; ++cbk) {
            f32x4 o = (f32x4){0.f, 0.f, 0.f, 0.f};
            const LAS unsigned char* vr = buf + (16 * cbk + fr) * VROW + fq * 16;
#pragma unroll
            for (int k = 0; k < 4; ++k) o = __builtin_amdgcn_mfma_f32_16x16x32_bf16(*(const LAS bf16x8*)(vr + k * 64), wf[k], o, 0, 0, 0);
            const int ch = g * 128 + 16 * cbk + 4 * fq;
            const float y0 = (o[0] + bs) * bf_lo(z[cbk].x), y1 = (o[1] + bs) * bf_hi(z[cbk].x), y2 = (o[2] + bs) * bf_lo(z[cbk].y), y3 = (o[3] + bs) * bf_hi(z[cbk].y);
            *(u32x2*)(OBp + tok * OB_LD + 1536 + ch) = (u32x2){cvt_pk_bf16(y0, y1), cvt_pk_bf16(y2, y3)};
        }
    }
}

#define XB_TMO      128
#define XB_XCNT(j)  (256  + 64 * (j))
#define XB_XSUB(j)  (1280 + 64 * (j))
#define XB_XGEN(j)  (2304 + 64 * (j))
#define XB_TOP      3328
#define XB_TOPGEN   3392
#define XCD_BAR_WORDS 3456
#define XB_SPIN_CAP (1u << 22)
__device__ __forceinline__ unsigned xb_ld(unsigned* p)              { return __hip_atomic_load(p, __ATOMIC_RELAXED, __HIP_MEMORY_SCOPE_AGENT); }
__device__ __forceinline__ unsigned xb_add(unsigned* p, unsigned v) { return __hip_atomic_fetch_add(p, v, __ATOMIC_RELAXED, __HIP_MEMORY_SCOPE_AGENT); }
__device__ __forceinline__ unsigned xb_xcc_id() { return (unsigned)__builtin_amdgcn_s_getreg((3 << 11) | 20) & 0xFu; }
#define XB_SPIN(cond, bar) do { unsigned _sp = 0; while (cond) { __builtin_amdgcn_s_sleep(1); \
    if ((++_sp & 255u) == 0u) { if (xb_ld(&(bar)[XB_TMO])) break; if (_sp > XB_SPIN_CAP) { atomicAdd(&(bar)[XB_TMO], 1u); break; } } } } while (0)
struct XcdBarrier { unsigned* bar; unsigned x; volatile LAS unsigned* st; };
__device__ __forceinline__ XcdBarrier xcd_barrier_post(unsigned* bar, volatile LAS unsigned* st) {
    XcdBarrier b; b.bar = bar; b.x = xb_xcc_id(); b.st = st;
    if (threadIdx.x == 0) (void)xb_add(&bar[XB_XCNT(b.x)], 1u);
    return b;
}
__device__ __forceinline__ void xcd_barrier_complete(unsigned* bar, unsigned x, unsigned& nloc, unsigned& nx) {
    const unsigned G = gridDim.x * gridDim.y * gridDim.z;
    unsigned sum, cnt, mine, sp = 0u;
    for (;;) {
        sum = 0u; cnt = 0u; mine = 0u;
#pragma unroll
        for (unsigned j = 0; j < 16; ++j) { const unsigned c = xb_ld(&bar[XB_XCNT(j)]); sum += c; cnt += (c > 0u) ? 1u : 0u; mine = (j == x) ? c : mine; }
        if (sum == G) break;
        __builtin_amdgcn_s_sleep(1);
        if ((++sp & 255u) == 0u) { if (xb_ld(&bar[XB_TMO])) break; if (sp > XB_SPIN_CAP) { atomicAdd(&bar[XB_TMO], 1u); break; } }
    }
    nloc = mine > 0u ? mine : 1u; nx = cnt > 0u ? cnt : 1u;
}
__device__ __forceinline__ void xcd_barrier(const XcdBarrier& b) {
    asm volatile("s_waitcnt vmcnt(0)" ::: "memory");
    __syncthreads();
    if (threadIdx.x == 0) {
        unsigned* bar = b.bar;
        __builtin_amdgcn_s_waitcnt(0);
        unsigned nloc = b.st[0], nx = b.st[1];
        if (nloc == 0u) { xcd_barrier_complete(bar, b.x, nloc, nx); b.st[0] = nloc; b.st[1] = nx; }
        const unsigned old = xb_add(&bar[XB_XSUB(b.x)], 1u);
        const unsigned gen = old / nloc;
        if (old + 1u == (gen + 1u) * nloc) {
            __builtin_amdgcn_fence(__ATOMIC_RELEASE, "agent");
            asm volatile("s_waitcnt vmcnt(0)" ::: "memory");
            const unsigned og = xb_add(&bar[XB_TOP], 1u);
            const unsigned tg = og / nx;
            if (og + 1u == (tg + 1u) * nx) xb_add(&bar[XB_TOPGEN], 1u);
            else XB_SPIN(xb_ld(&bar[XB_TOPGEN]) == tg, bar);
            __builtin_amdgcn_fence(__ATOMIC_ACQUIRE, "agent");
            xb_add(&bar[XB_XGEN(b.x)], 1u);
            asm volatile("s_waitcnt vmcnt(0)" ::: "memory");
        } else {
            XB_SPIN(xb_ld(&bar[XB_XGEN(b.x)]) == gen, bar);
            __builtin_amdgcn_fence(__ATOMIC_ACQUIRE, "agent");
            asm volatile("s_waitcnt vmcnt(0)" ::: "memory");
        }
    }
    __syncthreads();
}

template <int TMASK>
__global__ void __launch_bounds__(NWAVES * 64, 2) fwd_mega_t(Args args) {
    extern __shared__ __attribute__((aligned(16))) unsigned char lds_raw[];
    LAS unsigned char* lds = (LAS unsigned char*)lds_raw;
    const int tid = threadIdx.x, lane = tid & 63, wave = __builtin_amdgcn_readfirstlane(tid >> 6);
    const int G = gridDim.x, bx = blockIdx.x;
    const int vcu = (G % 8 == 0) ? (bx % 8) * (G / 8) + bx / 8 : bx;
    unsigned char* ws = args.ws;
    const float* x = args.in[0]; const float* mem = args.in[1]; const float* norm_gain = args.in[2]; const float* mem_gain = args.in[3];
    const float* w_in = args.in[4]; const float* sink = args.in[5]; const float* ln_g = args.in[6]; const float* ln_b = args.in[7];
    const float* w_sp = args.in[8]; const float* b_sp = args.in[9]; const float* w_kv = args.in[10]; const float* w_bra = args.in[11];
    const float* w_brb = args.in[12]; const float* w_brc = args.in[13]; const float* w_out = args.in[14]; const float* fin_gain = args.in[15];
    bf16_t* WinT = (bf16_t*)(ws + WS_WINT); bf16_t* H = (bf16_t*)(ws + WS_H); bf16_t* WkvT = (bf16_t*)(ws + WS_WKVT); bf16_t* MemH = (bf16_t*)(ws + WS_MEMH);
    bf16_t* WbrT = (bf16_t*)(ws + WS_WBRT); bf16_t* WoutT = (bf16_t*)(ws + WS_WOUTT); bf16_t* QKZ = (bf16_t*)(ws + WS_QKZ); bf16_t* OBp = (bf16_t*)(ws + WS_OB);
    bf16_t* KMEM = (bf16_t*)(ws + WS_KMEM); bf16_t* VMEMT = (bf16_t*)(ws + WS_VMEMT); float* PART1 = (float*)(ws + WS_PART1); float* PART2 = (float*)(ws + WS_PART2);
    bf16_t* MERGED = (bf16_t*)(ws + WS_MERGED);
    bf16_t* WSPB = (bf16_t*)(ws + 65536);
#if defined(CHK) && CHK == 1
    bf16_t* VAT = (bf16_t*)(ws + WS_OB); bf16_t* VBT = (bf16_t*)(ws + WS_OB + 16 * MiB);
#else
    bf16_t* VAT = (bf16_t*)((unsigned char*)args.out + DO_VAT); bf16_t* VBT = (bf16_t*)((unsigned char*)args.out + DO_VBT);
#endif
    const int lo = args.ph_lo, hi = args.ph_hi;
    const bool defer_w = (G == 256) && (hi - lo > 1);
#ifndef PH_MASK
#define PH_MASK 127
#endif
#define IN(k) ((((PH_MASK) >> (k)) & 1) && ((TMASK >> (k)) & 1) && lo <= (k) && (k) < hi)
    volatile LAS unsigned* MISC = (volatile LAS unsigned*)(lds + LDS_BYTES - 64);
    if (tid < 16) MISC[tid] = 0u;
    __syncthreads();
    XcdBarrier xbar; xbar.bar = (unsigned*)ws; xbar.x = 0; xbar.st = MISC;
    if (hi - lo > 1) xbar = xcd_barrier_post((unsigned*)ws, MISC);
    if (args.chk == 0x7fffffff) cg::this_grid().sync();
#define SEAM(k) do { if (IN(k) && IN((k) + 1)) xcd_barrier(xbar); } while (0)

    if (IN(0)) {
        const int gw = vcu * NWAVES + wave, NGW = G * NWAVES;
        p0_tiles(P0W{w_in, w_kv, w_bra, w_brb, w_brc, w_out, WinT, WkvT, WbrT, WoutT}, defer_w ? 0 : 2, vcu, G, tid, (LAS float*)lds);
        for (int m = 4 * gw; m < M; m += 4 * NGW)
            rms_rows_to_bf16<4>(x + (size_t)m * DM, norm_gain, H + (size_t)m * DM, lane);
        for (int m = gw; m < MM; m += NGW) rms_row_to_bf16(mem + (size_t)m * DM, mem_gain, MemH + (size_t)m * DM, lane);
        { const int gt = gw * 64 + lane;
          if (gt < 12 * 128 * 128 / 8) { const f32x4 a = *(const f32x4*)(w_sp + (size_t)gt * 8), b = *(const f32x4*)(w_sp + (size_t)gt * 8 + 4); *(u32x4*)(WSPB + (size_t)gt * 8) = pack8(a, b); } }
    }
    SEAM(0);
    if (IN(1)) {
        SchedP1 S{bx, G, H, WinT, MemH, WkvT, QKZ, VAT, VBT, KMEM, VMEMT, PART1};
        EpiP1 E;
        pg8::gemm_phase<EpiP1, SchedP1>(lds, S, E);
        if (defer_w && bx >= 160) p0_tiles(P0W{w_in, w_kv, w_bra, w_brb, w_brc, w_out, WinT, WkvT, WbrT, WoutT}, 1, bx - 160, 96, tid, (LAS float*)lds);
    }
    SEAM(1);
    if (IN(2)) {
        for (int it = vcu; it < 2304; it += G) {
            if (it < 512) {
                const int bh = it >> 5, qt = it & 31, b = bh >> 2, hd = bh & 3; const size_t tok0 = (size_t)b * SEQ + qt * 128;
                attn_item<256, 8, 8, false>(lds, tid, QKZ + tok0 * QKZ_LD + 5120 + hd * 256, QKZ_LD, KMEM + (size_t)b * 256 * 1024 + hd * 256, 1024,
                                            VMEMT + (size_t)hd * 256 * 1024 + b * 256, 1024, 0, 256, 0.f, 0.f, LOG2E * 0.0625f,
                                            QKZ + tok0 * QKZ_LD + 6144 + hd * 256, QKZ_LD, OBp + tok0 * OB_LD + 3072 + hd * 256, OB_LD);
            } else if (it < 2048) {
                const int idx = it - 512, r = idx % 3, rest = idx / 3, n = rest & 31, bh = rest >> 5, b = bh >> 2, hkv = bh & 3, hq = hkv * 3 + r;
                const long tok0 = (long)b * SEQ + n * 128;
                const float slope = (hq < 8) ? __builtin_amdgcn_exp2f(-(float)(hq + 1)) : __builtin_amdgcn_exp2f(-((float)(hq - 8) + 0.5f));
                attn_item<128, 12, 9, true>(lds, tid, QKZ + tok0 * QKZ_LD + hq * 128, QKZ_LD, QKZ + (tok0 - 128) * QKZ_LD + 1536 + hkv * 128, QKZ_LD,
                                            VAT + (long)hkv * 128 * M + (tok0 - 128), M, (n == 0) ? 128 : 0, (n == 31) ? 256 : 384,
                                            slope * LOG2E, sink[hq] * LOG2E, LOG2E * 0.08838834764831845f,
                                            QKZ + tok0 * QKZ_LD + 2048 + hq * 128, QKZ_LD, OBp + tok0 * OB_LD + hq * 128, OB_LD);
            } else {
                const int idx = it - 2048, ck = idx >> 1, hf = idx & 1;
                gate_item<6>(lds, tid, ck, hf * 6, VBT, PART1, ln_g, ln_b, WSPB, b_sp, QKZ, OBp);
            }
        }
        __syncthreads();
    }
    SEAM(2);
    if (IN(3)) {
        SchedP3 S{bx, G, H, WinT, OBp, WbrT, MERGED};
        EpiP3 E{(const char*)(ws + WS_SG) + (size_t)bx * 16 * 8192, (const char*)(ws + WS_SM) + (size_t)bx * 16 * 8192};
#ifdef P3_ZFILL
        { GAS u32x4* gz = (GAS u32x4*)(E.sgb + (tid >> 6) * 16384 + (tid & 63) * 16); GAS u32x4* mz = (GAS u32x4*)(E.smb + (tid >> 6) * 32768 + (tid & 63) * 16);
          for (int i = 0; i < 16; ++i) gz[i * 64] = (u32x4){0u, 0u, 0u, 0u};
          for (int i = 0; i < 32; ++i) mz[i * 64] = (u32x4){0u, 0u, 0u, 0u};
          asm volatile("s_waitcnt vmcnt(0)" ::: "memory"); __syncthreads(); }
#endif
        pg8::gemm_phase<EpiP3, SchedP3>(lds, S, E);
    }
    SEAM(3);
    if (IN(4)) {
        SchedP4 S{bx, G, MERGED, WoutT};
        EpiP4 E{(bf16_t*)(ws + WS_QKZ)};
        pg8::gemm_phase<EpiP4, SchedP4>(lds, S, E);
    }
    SEAM(4);
    if (IN(5)) {
        const int gw = vcu * NWAVES + wave, NGW = G * NWAVES;
        const bf16_t* DELTA = (const bf16_t*)(ws + WS_QKZ);
        const f32x4* gr = (const f32x4*)fin_gain + lane;
        for (int m0 = 2 * gw; m0 < M; m0 += 2 * NGW) {
            f32x4 v[2][8]; u32x2 d[2][8];
#pragma unroll
            for (int q = 0; q < 2; ++q) { const f32x4* xr = (const f32x4*)(x + (size_t)(m0 + q) * DM) + lane; const u32x2* dr = (const u32x2*)(DELTA + (size_t)(m0 + q) * DM) + lane;
#pragma unroll
                for (int j = 0; j < 8; ++j) { v[q][j] = __builtin_nontemporal_load(xr + 64 * j); d[q][j] = dr[64 * j]; } }
#pragma unroll
            for (int q = 0; q < 2; ++q) {
                float t = 0.f;
#pragma unroll
                for (int j = 0; j < 8; ++j) { v[q][j] += (f32x4){bf_lo(d[q][j].x), bf_hi(d[q][j].x), bf_lo(d[q][j].y), bf_hi(d[q][j].y)};
                    t += (v[q][j][0] * v[q][j][0] + v[q][j][1] * v[q][j][1]) + (v[q][j][2] * v[q][j][2] + v[q][j][3] * v[q][j][3]); }
                const float rstd = 1.0f / sqrtf(wave_sum(t) * (1.f / DM) + EPS);
                f32x4* o = (f32x4*)(args.out + (size_t)(m0 + q) * DM) + lane;
#pragma unroll
                for (int j = 0; j < 8; ++j) __builtin_nontemporal_store(v[q][j] * rstd * gr[64 * j], o + 64 * j);
            }
        }
    }
#ifdef CHK
    if (IN(6)) {
        const int gw = vcu * NWAVES + wave, NGW = G * NWAVES;
        for (int m = gw; m < M; m += NGW) {
            for (int c = lane; c < DM; c += 64) {
                float v = 0.f;
                if (args.chk == 2) v = bf_lo(OBp[(size_t)m * OB_LD + c]) + bf_lo(OBp[(size_t)m * OB_LD + 2048 + c]);
                else if (args.chk == 3) v = bf_lo(MERGED[(size_t)m * DM + c]);
                else if (args.chk == 1) { v = bf_lo(QKZ[(size_t)m * QKZ_LD + c]) + bf_lo(QKZ[(size_t)m * QKZ_LD + 2048 + c]) + bf_lo(QKZ[(size_t)m * QKZ_LD + 4096 + c]) + (c < 1024 ? bf_lo(QKZ[(size_t)m * QKZ_LD + 6144 + c]) : 0.f)
                        + bf_lo(VAT[(size_t)(c & 511) * M + m]) + bf_lo(VBT[(size_t)(c % 1536) * M + m]) + PART1[(size_t)m * 24 + (c % 24)] + bf_lo(KMEM[(size_t)(m & 1023) * 1024 + (c & 1023)]) + bf_lo(VMEMT[(size_t)(m & 1023) * 1024 + (c & 1023)]); }
                else if (args.chk == 0) v = bf_lo(H[(size_t)m * DM + c]) + bf_lo(WinT[(size_t)m * DM + c]) + bf_lo(WbrT[(size_t)(m & 2047) * OB_LD + c]) + bf_lo(WbrT[(size_t)(m & 2047) * OB_LD + 2048 + c]) + bf_lo(WoutT[(size_t)(m & 2047) * DM + c]) + bf_lo(WkvT[(size_t)(m & 2047) * DM + c]) + bf_lo(MemH[(size_t)(m & 1023) * DM + c]);
                args.out[(size_t)m * DM + c] = v;
            }
        }
    }
#endif
#undef IN
#undef SEAM
}

template <int P> static void launch_one(int grid, hipStream_t stream, const Args& a) {
    static bool init = false;
    if (!init) { (void)hipFuncSetAttribute((const void*)fwd_mega_t<(1 << P)>, hipFuncAttributeMaxDynamicSharedMemorySize, LDS_BYTES); init = true; }
    hipLaunchKernelGGL(fwd_mega_t<(1 << P)>, dim3(grid), dim3(NWAVES * 64), LDS_BYTES, stream, a);
}
static void launch_phase(int p, int grid, hipStream_t stream, const Args& a) {
    switch (p) { case 0: launch_one<0>(grid, stream, a); break; case 1: launch_one<1>(grid, stream, a); break; case 2: launch_one<2>(grid, stream, a); break;
                 case 3: launch_one<3>(grid, stream, a); break; case 4: launch_one<4>(grid, stream, a); break; case 5: launch_one<5>(grid, stream, a); break; default: launch_one<6>(grid, stream, a); break; }
}
extern "C" void kernel_launch(void* const* d_in, const int* in_sizes, int n_in, void* d_out, int out_size, void* d_ws, size_t ws_size, hipStream_t stream) {
    static int grid = 0;
    if (grid == 0) {
        if (n_in != 16 || in_sizes[0] != M * DM || out_size != M * DM || ws_size < WS_END) {
            fprintf(stderr, "kernel_launch: unexpected shapes / workspace (n_in %d, in0 %d, out %d, ws %zu < %zu); nothing launched\n", n_in, n_in > 0 ? in_sizes[0] : -1, out_size, ws_size, (size_t)WS_END);
            grid = -1; return; }
        int dev = 0, cus = 0, per_cu = 0;
        if (hipGetDevice(&dev) != hipSuccess || hipDeviceGetAttribute(&cus, hipDeviceAttributeMultiprocessorCount, dev) != hipSuccess) { grid = -1; return; }
        if (hipFuncSetAttribute((const void*)fwd_mega_t<127>, hipFuncAttributeMaxDynamicSharedMemorySize, LDS_BYTES) != hipSuccess) { fprintf(stderr, "kernel_launch: hipFuncSetAttribute failed\n"); grid = -1; return; }
        if (hipOccupancyMaxActiveBlocksPerMultiprocessor(&per_cu, (const void*)fwd_mega_t<127>, NWAVES * 64, LDS_BYTES) != hipSuccess || per_cu < 1) { fprintf(stderr, "kernel_launch: occupancy query says %d blocks per CU\n", per_cu); (void)hipGetLastError(); grid = -1; return; }
        grid = cus < 256 ? cus : 256;
    }
    if (grid < 0) return;
    Args a{};
    for (int i = 0; i < 16; ++i) a.in[i] = (const float*)d_in[i];
    a.out = (float*)d_out; a.ws = (unsigned char*)d_ws;
#ifdef CHK
    a.chk = CHK;
    for (int p = 0; p <= CHK; ++p) { a.ph_lo = p; a.ph_hi = p + 1; launch_phase(p, grid, stream, a); }
    a.ph_lo = 6; a.ph_hi = 7; launch_phase(6, grid, stream, a);
#elif MK_MULTI
    for (int p = 0; p < 6; ++p) { a.ph_lo = p; a.ph_hi = p + 1; launch_phase(p, grid, stream, a); }
#else
    a.ph_lo = 0; a.ph_hi = 6;
    if (hipMemsetAsync(d_ws, 0, 16384, stream) != hipSuccess) { fprintf(stderr, "kernel_launch: memset of barrier words failed\n"); return; }
    void* kargs[] = {&a};
    hipError_t e = hipLaunchCooperativeKernel((const void*)fwd_mega_t<127>, dim3(grid), dim3(NWAVES * 64), kargs, LDS_BYTES, stream);
    if (e != hipSuccess) fprintf(stderr, "kernel_launch: cooperative launch failed: %s (grid %d)\n", hipGetErrorString(e), grid);
#endif
}
```
